# Optimizing an MI355X kernel written in HIP

```python
import jax, jax.numpy as jnp
from jax import lax
import numpy as np

D_MODEL = 2048
BATCH = 4
SEQ = 4096
DEPTH = 4
DEC_BATCH = 32
DEC_SEQ = 64
PAST_LEN = 1024

CHUNK = 64
GMLP_CHUNK = 128
GMLP_GROUPS = 12
GMLP_GROUP_DIM = 128
GMLP_WIDTH = GMLP_GROUPS * GMLP_GROUP_DIM
SWA_HEADS = 24
SWA_KV_HEADS = 4
SWA_HEAD_DIM = 64
SWA_GROUP = SWA_HEADS // SWA_KV_HEADS
SWA_WIDTH = SWA_HEADS * SWA_HEAD_DIM
SWA_KV_WIDTH = SWA_KV_HEADS * SWA_HEAD_DIM
WINDOW = 128
WINDOW_CHUNKS = WINDOW // CHUNK
BAND = (WINDOW_CHUNKS + 1) * CHUNK
ROPE_THETA = 500000.0
ROPE_DIM = SWA_HEAD_DIM // 4
MEM_TOKENS = 256
MEM_HEADS = 4
MEM_HEAD_DIM = 256
MEM_WIDTH = MEM_HEADS * MEM_HEAD_DIM
N_BRANCHES = 3
FFN_HIDDEN = 4 * D_MODEL
IN_WIDTH = 2 * GMLP_WIDTH + SWA_WIDTH + 2 * SWA_KV_WIDTH + MEM_WIDTH + N_BRANCHES * D_MODEL
EPS = 1e-6
NEG = -1e30

kernel_name = "hybrid_streaming_gmlp_swa_memory_step"


def rmsnorm(x, g):
    xf = x.astype(jnp.float32)
    y = xf * lax.rsqrt(jnp.mean(xf * xf, axis=-1, keepdims=True) + EPS)
    return (y * g.astype(jnp.float32)).astype(x.dtype)


def layernorm(x, g, b):
    xf = x.astype(jnp.float32)
    mu = jnp.mean(xf, axis=-1, keepdims=True)
    var = jnp.mean(jnp.square(xf - mu), axis=-1, keepdims=True)
    y = (xf - mu) * lax.rsqrt(var + EPS) * g.astype(jnp.float32) + b.astype(jnp.float32)
    return y.astype(x.dtype)


def partial_rope(x, pos):
    half = ROPE_DIM // 2
    inv = ROPE_THETA ** (-jnp.arange(half, dtype=jnp.float32) / half)
    ang = pos.astype(jnp.float32)[:, None] * inv[None, :]
    cos = jnp.cos(ang)[:, None, :]
    sin = jnp.sin(ang)[:, None, :]
    xr = x[..., :ROPE_DIM].astype(jnp.float32)
    x1, x2 = xr[..., :half], xr[..., half:]
    rot = jnp.concatenate([x1 * cos - x2 * sin, x2 * cos + x1 * sin], axis=-1).astype(x.dtype)
    return jnp.concatenate([rot, x[..., ROPE_DIM:]], axis=-1)


def split_in(z):
    sizes = (GMLP_WIDTH, GMLP_WIDTH, SWA_WIDTH, SWA_KV_WIDTH, SWA_KV_WIDTH, MEM_WIDTH)
    idx = [int(i) for i in np.cumsum(sizes)]
    return jnp.split(z, idx, axis=-1)


def gmlp_spatial(vc, w_s, b_s):
    L = vc.shape[2]
    w = jnp.tril(w_s[:, :L, :L]).astype(vc.dtype)
    bias = jnp.transpose(b_s[:, :L])[None, None, :, :, None].astype(vc.dtype)
    return jnp.einsum('gij,bcjgd->bcigd', w, vc) + bias


def mixer_projections(h, pos, chunk_len, w_in, ln_g, ln_b, w_s, b_s):
    B, S, _ = h.shape
    a_u, a_v, bq, bk, bv, cq, gate_logits = split_in(h @ w_in)
    u = jax.nn.gelu(a_u)
    v_rows = layernorm(jax.nn.gelu(a_v), ln_g, ln_b)
    vc = v_rows.reshape(B, S // chunk_len, chunk_len, GMLP_GROUPS, GMLP_GROUP_DIM)
    o_a = u * gmlp_spatial(vc, w_s, b_s).reshape(B, S, GMLP_WIDTH)
    q = partial_rope(bq.reshape(B, S, SWA_HEADS, SWA_HEAD_DIM), pos)
    k = partial_rope(bk.reshape(B, S, SWA_KV_HEADS, SWA_HEAD_DIM), pos)
    v = bv.reshape(B, S, SWA_KV_HEADS, SWA_HEAD_DIM)
    cq = cq.reshape(B, S, MEM_HEADS, MEM_HEAD_DIM)
    gates = jax.nn.sigmoid(gate_logits.astype(jnp.float32)).astype(h.dtype)
    gates = gates.reshape(B, S, N_BRANCHES, D_MODEL)
    return o_a, v_rows, q, k, v, cq, gates


def sink_softmax(scores, sink):
    s = jnp.broadcast_to(sink.astype(jnp.float32).reshape(SWA_KV_HEADS, SWA_GROUP, 1, 1),
                         scores.shape[:-1] + (1,))
    p = jax.nn.softmax(jnp.concatenate([scores, s], axis=-1), axis=-1)
    return p[..., :-1]


def swa_prompt(q, k, v, sink):
    B, S = q.shape[:2]
    n_c = S // CHUNK
    pad = WINDOW_CHUNKS * CHUNK
    kp = jnp.pad(k, ((0, 0), (pad, 0), (0, 0), (0, 0))).reshape(B, n_c + WINDOW_CHUNKS, CHUNK, SWA_KV_HEADS, SWA_HEAD_DIM)
    vp = jnp.pad(v, ((0, 0), (pad, 0), (0, 0), (0, 0))).reshape(B, n_c + WINDOW_CHUNKS, CHUNK, SWA_KV_HEADS, SWA_HEAD_DIM)
    band_k = jnp.concatenate([kp[:, j:j + n_c] for j in range(WINDOW_CHUNKS + 1)], axis=2)
    band_v = jnp.concatenate([vp[:, j:j + n_c] for j in range(WINDOW_CHUNKS + 1)], axis=2)
    qc = q.reshape(B, n_c, CHUNK, SWA_KV_HEADS, SWA_GROUP, SWA_HEAD_DIM)
    scores = jnp.einsum('bcqhgd,bckhd->bchgqk', qc, band_k).astype(jnp.float32) * (SWA_HEAD_DIM ** -0.5)
    kpos = (jnp.arange(n_c)[:, None] - WINDOW_CHUNKS) * CHUNK + jnp.arange(BAND)[None, :]
    valid = (kpos >= 0)[None, :, None, None, None, :]
    scores = jnp.where(valid, scores, NEG)
    p = sink_softmax(scores, sink).astype(v.dtype)
    o = jnp.einsum('bchgqk,bckhd->bcqhgd', p, band_v)
    return o.reshape(B, S, SWA_WIDTH)


def swa_sample(q, k, v, cache_k, cache_v, sink):
    B, S = q.shape[:2]
    k_all = jnp.concatenate([cache_k.astype(k.dtype), k], axis=1)
    v_all = jnp.concatenate([cache_v.astype(v.dtype), v], axis=1)
    qg = q.reshape(B, S, SWA_KV_HEADS, SWA_GROUP, SWA_HEAD_DIM)
    scores = jnp.einsum('bqhgd,bkhd->bhgqk', qg, k_all).astype(jnp.float32) * (SWA_HEAD_DIM ** -0.5)
    p = sink_softmax(scores, sink).astype(v.dtype)
    o = jnp.einsum('bhgqk,bkhd->bqhgd', p, v_all)
    return o.reshape(B, S, SWA_WIDTH)


def memory_kv(mem, g, w_mk, w_mv):
    B = mem.shape[0]
    m = rmsnorm(mem, g)
    k = (m @ w_mk).reshape(B, MEM_TOKENS, MEM_HEADS, MEM_HEAD_DIM)
    v = (m @ w_mv).reshape(B, MEM_TOKENS, MEM_HEADS, MEM_HEAD_DIM)
    return k, v


def memory_attend(cq, mk, mv):
    B, S = cq.shape[:2]
    scores = jnp.einsum('bshd,bmhd->bhsm', cq, mk.astype(cq.dtype)).astype(jnp.float32) * (MEM_HEAD_DIM ** -0.5)
    p = jax.nn.softmax(scores, axis=-1).astype(cq.dtype)
    o = jnp.einsum('bhsm,bmhd->bshd', p, mv.astype(cq.dtype))
    return o.reshape(B, S, MEM_WIDTH)


def merge_branches(o_a, o_b, o_c, gates, w_pa, w_pb, w_pc, w_o):
    merged = (gates[..., 0, :] * (o_a @ w_pa)
              + gates[..., 1, :] * (o_b @ w_pb)
              + gates[..., 2, :] * (o_c @ w_pc))
    return merged @ w_o


def ffn_sublayer(x, g_pre, g_post, w_up, w_down):
    h = rmsnorm(x, g_pre)
    return x + rmsnorm(jnp.square(jax.nn.relu(h @ w_up)) @ w_down, g_post)


def setup_inputs(seed: int = 0) -> dict:
    key = jax.random.key(seed)
    ks = jax.random.split(key, 26)

    def nrm(k, shape, scale=1.0):
        return jax.random.normal(k, shape, jnp.float32) * scale

    return {
        "x_prompt": nrm(ks[0], (BATCH, SEQ, D_MODEL)),
        "x_sample": nrm(ks[1], (DEC_BATCH, DEC_SEQ, D_MODEL)),
        "cache_swa_k": nrm(ks[2], (DEPTH, DEC_BATCH, WINDOW, SWA_KV_HEADS, SWA_HEAD_DIM)),
        "cache_swa_v": nrm(ks[3], (DEPTH, DEC_BATCH, WINDOW, SWA_KV_HEADS, SWA_HEAD_DIM)),
        "cache_mem_k": nrm(ks[4], (DEPTH, DEC_BATCH, MEM_TOKENS, MEM_HEADS, MEM_HEAD_DIM)),
        "cache_mem_v": nrm(ks[5], (DEPTH, DEC_BATCH, MEM_TOKENS, MEM_HEADS, MEM_HEAD_DIM)),
        "mem_prompt": nrm(ks[6], (BATCH, MEM_TOKENS, D_MODEL)),
        "w_in": nrm(ks[7], (DEPTH, D_MODEL, IN_WIDTH), D_MODEL ** -0.5),
        "ln_v_g": 1.0 + nrm(ks[8], (DEPTH, GMLP_WIDTH), 0.02),
        "ln_v_b": nrm(ks[9], (DEPTH, GMLP_WIDTH), 0.02),
        "w_s": nrm(ks[10], (DEPTH, GMLP_GROUPS, GMLP_CHUNK, GMLP_CHUNK), GMLP_CHUNK ** -0.5),
        "b_s": 1.0 + nrm(ks[11], (DEPTH, GMLP_GROUPS, GMLP_CHUNK), 0.1),
        "sinks": nrm(ks[12], (DEPTH, SWA_HEADS), 0.5),
        "mem_norm": 1.0 + nrm(ks[13], (DEPTH, D_MODEL), 0.02),
        "w_mem_k": nrm(ks[14], (DEPTH, D_MODEL, MEM_WIDTH), D_MODEL ** -0.5),
        "w_mem_v": nrm(ks[15], (DEPTH, D_MODEL, MEM_WIDTH), D_MODEL ** -0.5),
        "w_pa": nrm(ks[16], (DEPTH, GMLP_WIDTH, D_MODEL), GMLP_WIDTH ** -0.5),
        "w_pb": nrm(ks[17], (DEPTH, SWA_WIDTH, D_MODEL), SWA_WIDTH ** -0.5),
        "w_pc": nrm(ks[18], (DEPTH, MEM_WIDTH, D_MODEL), MEM_WIDTH ** -0.5),
        "w_o": nrm(ks[19], (DEPTH, D_MODEL, D_MODEL), D_MODEL ** -0.5),
        "norm_mix_pre": 1.0 + nrm(ks[20], (DEPTH, D_MODEL), 0.02),
        "norm_mix_post": 1.0 + nrm(ks[21], (DEPTH, D_MODEL), 0.02),
        "norm_ffn_pre": 1.0 + nrm(ks[22], (DEPTH, D_MODEL), 0.02),
        "norm_ffn_post": 1.0 + nrm(ks[23], (DEPTH, D_MODEL), 0.02),
        "w_up": nrm(ks[24], (DEPTH, D_MODEL, FFN_HIDDEN), D_MODEL ** -0.5),
        "w_down": nrm(ks[25], (DEPTH, FFN_HIDDEN, D_MODEL), FFN_HIDDEN ** -0.5),
    }


def reference(x_prompt, x_sample, cache_swa_k, cache_swa_v, cache_mem_k, cache_mem_v, mem_prompt,
              w_in, ln_v_g, ln_v_b, w_s, b_s, sinks, mem_norm, w_mem_k, w_mem_v,
              w_pa, w_pb, w_pc, w_o, norm_mix_pre, norm_mix_post, norm_ffn_pre, norm_ffn_post,
              w_up, w_down):
    seq_p = x_prompt.shape[1]
    seq_s = x_sample.shape[1]
    pos_p = jnp.arange(seq_p, dtype=jnp.int32)
    pos_s = PAST_LEN + jnp.arange(seq_s, dtype=jnp.int32)
    yp, ys = x_prompt, x_sample
    k_p, v_p, mk_p, mv_p, k_s, v_s, gv_s = [], [], [], [], [], [], []
    for l in range(DEPTH):
        h = rmsnorm(yp, norm_mix_pre[l])
        o_a, _, q, k, v, cq, gates = mixer_projections(h, pos_p, GMLP_CHUNK, w_in[l], ln_v_g[l], ln_v_b[l], w_s[l], b_s[l])
        o_b = swa_prompt(q, k, v, sinks[l])
        mk, mv = memory_kv(mem_prompt, mem_norm[l], w_mem_k[l], w_mem_v[l])
        o_c = memory_attend(cq, mk, mv)
        mix = merge_branches(o_a, o_b, o_c, gates, w_pa[l], w_pb[l], w_pc[l], w_o[l])
        yp = yp + rmsnorm(mix, norm_mix_post[l])
        yp = ffn_sublayer(yp, norm_ffn_pre[l], norm_ffn_post[l], w_up[l], w_down[l])
        k_p.append(k[:, -WINDOW:])
        v_p.append(v[:, -WINDOW:])
        mk_p.append(mk)
        mv_p.append(mv)
        hs = rmsnorm(ys, norm_mix_pre[l])
        o_a, v_rows, q, k, v, cq, gates = mixer_projections(hs, pos_s, seq_s, w_in[l], ln_v_g[l], ln_v_b[l], w_s[l], b_s[l])
        o_b = swa_sample(q, k, v, cache_swa_k[l], cache_swa_v[l], sinks[l])
        o_c = memory_attend(cq, cache_mem_k[l], cache_mem_v[l])
        mix = merge_branches(o_a, o_b, o_c, gates, w_pa[l], w_pb[l], w_pc[l], w_o[l])
        ys = ys + rmsnorm(mix, norm_mix_post[l])
        ys = ffn_sublayer(ys, norm_ffn_pre[l], norm_ffn_post[l], w_up[l], w_down[l])
        k_s.append(k)
        v_s.append(v)
        gv_s.append(v_rows)
    new_swa_k_prompt = jnp.stack(k_p)
    new_swa_v_prompt = jnp.stack(v_p)
    new_mem_k_prompt = jnp.stack(mk_p)
    new_mem_v_prompt = jnp.stack(mv_p)
    new_swa_k_sample = jnp.stack(k_s)
    new_swa_v_sample = jnp.stack(v_s)
    new_gmlp_v_sample = jnp.stack(gv_s)
    return (yp, ys, new_swa_k_prompt, new_swa_v_prompt, new_mem_k_prompt, new_mem_v_prompt,
            new_swa_k_sample, new_swa_v_sample, new_gmlp_v_sample)
```

```cpp
#include <hip/hip_runtime.h>
#include <cstdio>
#include <cstdint>

#ifndef PROBE_REP_MIX
#define PROBE_REP_MIX 1
#endif
#ifndef PROBE_REP_CONV
#define PROBE_REP_CONV 1
#endif
constexpr int DM = 2048, NB = 4, SEQ = 4096, DEPTH = 4, DB = 32, DS = 64, PAST = 1024;
constexpr int MP = NB * SEQ, MS = DB * DS, MT = MP + MS;
constexpr int INW = 12288, FF = 8192, OCW = 4096;
constexpr int C_U = 0, C_GV = 1536, C_Q = 3072, C_K = 4608, C_V = 4864, C_CQ = 5120, C_G = 6144;
constexpr int GW = 1536;
constexpr size_t ZO_U = 0, ZO_GV = (size_t)(16384 + 2048) * C_GV, ZO_Q = (size_t)(16384 + 2048) * C_Q, ZO_KV = (size_t)(16384 + 2048) * C_K, ZO_CQ = (size_t)(16384 + 2048) * C_CQ, ZO_GATE_B = (size_t)(16384 + 2048) * C_G * 2;
constexpr int ZW_U = 1536, ZW_GV = 1536, ZW_Q = 1536, ZW_KV = 512, ZW_CQ = 1024, ZW_GATE_B = 6144;
constexpr float EPS = 1e-6f, LOG2E = 1.4426950408889634f;
constexpr size_t O_Y = 0;
constexpr size_t O_KP = (size_t)MT * DM;
constexpr size_t O_VP = O_KP + (size_t)DEPTH * NB * 128 * 256;
constexpr size_t O_MKP = O_VP + (size_t)DEPTH * NB * 128 * 256;
constexpr size_t O_MVP = O_MKP + (size_t)DEPTH * 1024 * 1024;
constexpr size_t O_KS = O_MVP + (size_t)DEPTH * 1024 * 1024;
constexpr size_t O_VS = O_KS + (size_t)DEPTH * MS * 256;
constexpr size_t O_GV = O_VS + (size_t)DEPTH * MS * 256;
constexpr size_t O_END = O_GV + (size_t)DEPTH * MS * GW;
static_assert(O_END == 63963136, "output size");

constexpr size_t MiB = 1u << 20;
constexpr size_t WS_CTL = 0, CTL_ZERO_BYTES = 1 * MiB;
constexpr size_t WS_ROPE = 1 * MiB;
constexpr size_t WS_WS = 2 * MiB;
constexpr size_t WS_STATS = 4 * MiB;
constexpr size_t WS_SIG = 7 * MiB + MiB / 2;
constexpr size_t WS_MN = 8 * MiB;
constexpr size_t WS_MKV = 24 * MiB;
constexpr size_t WS_W = 40 * MiB;
constexpr size_t W_G8 = 24 * MiB;
constexpr size_t W_IN = 0, W_MG = 48 * MiB, W_O = 64 * MiB, W_UP = 72 * MiB, W_DN = 104 * MiB, W_MEM = 136 * MiB, W_LAYER = 144 * MiB;
constexpr size_t WS_H = WS_W + 4 * W_LAYER;
constexpr size_t WS_Z = WS_H + 72 * MiB;
constexpr size_t WS_OC = WS_Z + 432 * MiB;
constexpr size_t WS_T1 = WS_OC + 144 * MiB;
constexpr size_t WS_T2 = WS_T1 + 72 * MiB;
constexpr size_t WS_PART = WS_T2 + 72 * MiB;
constexpr size_t WS_XB = WS_PART + 32 * MiB;
constexpr size_t WS_PARTM = WS_XB + 72 * MiB;
constexpr size_t WS_H8 = WS_PARTM + 32 * MiB;
constexpr size_t WS_END = WS_H8 + 36 * MiB;
constexpr int CW_TMO = 0, CW_CODE = 1, CW_QUEUE = 256  , CW_BAR = 4096;

constexpr int RING_BYTES = 131072, LDSCTL_OFF = RING_BYTES, MISC_OFF = LDSCTL_OFF + 320, LDS_BYTES = 147456;

#define GAS __attribute__((address_space(1)))
#define LAS __attribute__((address_space(3)))
typedef unsigned short bf16;
typedef short bf16x8 __attribute__((ext_vector_type(8)));
typedef short s16x4 __attribute__((ext_vector_type(4)));
typedef float f32x4 __attribute__((ext_vector_type(4)));
typedef float f32x16 __attribute__((ext_vector_type(16)));
typedef unsigned u32x4 __attribute__((ext_vector_type(4)));
typedef unsigned u32x2 __attribute__((ext_vector_type(2)));
typedef GAS unsigned gu32;

typedef float f32x2_t __attribute__((ext_vector_type(2))); typedef __bf16 bf16x2_t __attribute__((ext_vector_type(2)));
__device__ __forceinline__ unsigned cvt_pk_bf16(float lo, float hi) { const f32x2_t v = {lo, hi}; const bf16x2_t b = __builtin_convertvector(v, bf16x2_t); return __builtin_bit_cast(unsigned, b); }
__device__ __forceinline__ unsigned cvt_pk_asm(float lo, float hi) { unsigned r; asm volatile("v_cvt_pk_bf16_f32 %0, %1, %2" : "=v"(r) : "v"(lo), "v"(hi)); return r; }
__device__ __forceinline__ float bf_lo(unsigned w) { return __uint_as_float(w << 16); }
__device__ __forceinline__ float bf_hi(unsigned w) { return __uint_as_float(w & 0xffff0000u); }
__device__ __forceinline__ float fexp2(float x) { return __builtin_amdgcn_exp2f(x); }
__device__ __forceinline__ float frcp(float x) { return __builtin_amdgcn_rcpf(x); }
__device__ __forceinline__ float gelu_tanh(float x) { const float t = x + 0.044715f * x * x * x; return x * frcp(1.0f + fexp2(-2.302208198144325f * t)); }
__device__ __forceinline__ float sigmoidf_(float x) { return frcp(1.0f + fexp2(-LOG2E * x)); }
__device__ __forceinline__ int lane_id() { return (int)__builtin_amdgcn_mbcnt_hi(~0u, __builtin_amdgcn_mbcnt_lo(~0u, 0u)); }
#define LDS_WAIT() asm volatile("s_waitcnt lgkmcnt(0)" ::: "memory")
#define VM_WAIT() asm volatile("s_waitcnt vmcnt(0)" ::: "memory")
#define RLX_AGENT __ATOMIC_RELAXED, __HIP_MEMORY_SCOPE_AGENT

#ifndef WGM_WIDE
#define WGM_WIDE 8
#endif
namespace pg8 {
constexpr int BM = 256, BK = 64, HALF = 128, HTB = HALF * BK * 2, STAGE_BYTES = 8 * HTB, NXCD = 8, WGM = 4;
__host__ __device__ __forceinline__ int lds_byte(int r, int c) { const int st = (r >> 4) * 2 + (c >> 5), rr = r & 15, cc = c & 31, ob = rr * 64 + cc * 2; return st * 1024 + (ob ^ (((ob >> 9) & 1) << 5)); }
__host__ __device__ __forceinline__ void stage_rc(int b, int& R, int& C) { const int st = b / 1024, sb = b % 1024, swz = sb ^ (((sb >> 9) & 1) << 5); R = (st >> 1) * 16 + swz / 64; C = (st & 1) * 32 + (swz % 64) / 2; }
__host__ __device__ __forceinline__ int perm32(int rho) { const int n = rho >> 4, i = rho & 15; return 8 * (i >> 2) + 4 * n + (i & 3); }
struct Unit { int pm, pn, kq, nt; };
struct Gemm { const bf16* A; const bf16* Bt; int M, N, K; };
struct StaticOrder {
    int nM, nN, nwg, G, c;
    int ntk, wgm;
    __device__ void init(int M, int N, int K, int G_, int c_, int wgm_ = WGM) { nM = M / BM; nN = N / BM; nwg = nM * nN; G = G_; c = c_; ntk = K / BK; wgm = wgm_; }
    __device__ bool next(int i, Unit& u) const {
        const long L = (long)i * G + c; if (L >= nwg) return false;
        u.kq = 0; u.nt = ntk;
        int wgid = (int)L; { const int q = nwg / NXCD, r = nwg % NXCD, xcd = wgid % NXCD, off = wgid / NXCD; wgid = (xcd < r ? xcd * (q + 1) : r * (q + 1) + (xcd - r) * q) + off; }
        const int nig = wgm * nN, gid = wgid / nig, fm = gid * wgm, gsz = (nM - fm) < wgm ? (nM - fm) : wgm;
        u.pm = fm + ((wgid % nig) % gsz); u.pn = (wgid % nig) / gsz; return true;
    }
};
struct SplitOrder {
    StaticOrder P; int nP;
    __device__ void init(int K, int G_, int c_) { P.init(MP, DM, K, G_, c_); nP = P.nwg; }
    __device__ bool next(int i, Unit& u) const {
        Unit a; a.pm = 0; a.pn = 0; a.kq = 0; a.nt = P.ntk; const bool okp = P.next(i, a);
        const int s = i * P.G + P.c - nP; const bool oks = !okp && s >= 0 && s < 256;
        u.pm = okp ? a.pm : 64 + (s >> 5); u.pn = okp ? a.pn : ((s >> 2) & 7); u.kq = okp ? 0 : (s & 3); u.nt = okp ? P.ntk : (P.ntk >> 2);
        return okp || oks;
    }
};
typedef int v8i_t __attribute__((ext_vector_type(8))); typedef int v4i_t __attribute__((ext_vector_type(4)));
__device__ __forceinline__ v8i_t cat8(bf16x8 a, bf16x8 b) { const v4i_t x = __builtin_bit_cast(v4i_t, a), y = __builtin_bit_cast(v4i_t, b); return __builtin_shufflevector(x, y, 0, 1, 2, 3, 4, 5, 6, 7); }
template <class Epi, class Sched>
__device__ __forceinline__ void gemm_phase(LAS unsigned char* lds, const Gemm g, const Sched& S, const Epi& E) {
    static_assert(Epi::PERM, "all epilogues here use the 8-consecutive-column layout");
    int tid_ = threadIdx.x; asm volatile("" : "+v"(tid_));
    const int tid = tid_, wid = __builtin_amdgcn_readfirstlane(tid >> 6), lane = tid & 63, wr = wid >> 2, wc = wid & 3, fr = lane & 15, fq = lane >> 4;
    const int K = g.K;
    int sc127 = 127; asm volatile("" : "+v"(sc127));
    (void)sc127;
    unsigned voffA[2], voffB[2];
#pragma unroll
    for (int i = 0; i < 2; ++i) { int R, C; stage_rc(tid * 16 + i * 8192, R, C); const int Rb = (R & ~31) + perm32(R & 31);
        voffA[i] = (unsigned)(R * K + C) * 2u; voffB[i] = (unsigned)(Rb * K + C) * 2u; }
    const size_t kstep = (size_t)(BK * 2);
    const size_t hstep = (size_t)HALF * K * 2;
    const size_t tstep = 2 * hstep;
    const unsigned ldsw = (unsigned)wid * 1024u;
    const unsigned ldsb = (unsigned)(__UINTPTR_TYPE__)lds + ldsw;
    const int aoff = lds_byte(wr * 64 + fr, fq * 8), boff = lds_byte(wc * 32 + fr, fq * 8);
#define PG8_SA(b, h) (((b) * 2 + (h)) * HTB)
#define PG8_SB(b, h) ((4 + (b) * 2 + (h)) * HTB)
#define PG8_STAGE(bufoff, gbase, voff) do { _Pragma("unroll") for (int _i = 0; _i < 2; ++_i) \
        asm volatile("s_mov_b32 m0, %2\n\ts_nop 0\n\tglobal_load_lds_dwordx4 %0, %1" :: "v"((voff)[_i]), "s"((const char*)(gbase)), "s"(ldsb + (unsigned)((bufoff) + _i * 8192)) : "memory"); } while (0)
#define PG8_LDA(dst, b, h) do { _Pragma("unroll") for (int m = 0; m < 4; ++m) _Pragma("unroll") for (int k = 0; k < 2; ++k) dst[m][k] = *(const LAS bf16x8*)(lds + PG8_SA(b, h) + aoff + m * 2048 + k * 1024); } while (0)
#define PG8_LDB(dst, b, h) do { _Pragma("unroll") for (int n = 0; n < 2; ++n) _Pragma("unroll") for (int k = 0; k < 2; ++k) dst[n][k] = *(const LAS bf16x8*)(lds + PG8_SB(b, h) + boff + n * 2048 + k * 1024); } while (0)
#define PG8_MMA(ai, bj, At, Bt) do { __builtin_amdgcn_s_setprio(1); _Pragma("unroll") for (int m = 0; m < 4; ++m) _Pragma("unroll") for (int n = 0; n < 2; ++n) { \
        if constexpr (Epi::FP8) { const v8i_t a8_ = cat8(Bt[n][0], Bt[n][1]), b8_ = cat8(At[m][0], At[m][1]); \
            asm volatile("v_mfma_scale_f32_16x16x128_f8f6f4 %0, %1, %2, %0, %3, %3 op_sel_hi:[0,0,0]" : "+v"(acc[ai][bj][m][n]) : "v"(a8_), "v"(b8_), "v"(sc127)); } \
        else { _Pragma("unroll") for (int k = 0; k < 2; ++k) acc[ai][bj][m][n] = __builtin_amdgcn_mfma_f32_16x16x32_bf16(Bt[n][k], At[m][k], acc[ai][bj][m][n], 0, 0, 0); } } __builtin_amdgcn_s_setprio(0); } while (0)
#define PG8_WAIT_V(n) asm volatile("s_waitcnt vmcnt(" #n ")" ::: "memory")
#define PG8_WAIT_L(n) asm volatile("s_waitcnt lgkmcnt(" #n ")" ::: "memory")
#define PG8_BAR __builtin_amdgcn_s_barrier()
#define PG8_SCHED __builtin_amdgcn_sched_barrier(0)
    Unit cur, nxt; int ui = 0;
    if (!S.next(0, cur)) return;
    f32x4 acc[2][2][4][2];
#pragma unroll
    for (int a = 0; a < 2; ++a)
#pragma unroll
        for (int b = 0; b < 2; ++b)
#pragma unroll
            for (int m = 0; m < 4; ++m)
#pragma unroll
                for (int n = 0; n < 2; ++n) acc[a][b][m][n] = (f32x4){0.f, 0.f, 0.f, 0.f};
    bf16x8 At[4][2], B0[2][2], B1[2][2];
    const char* cA = (const char*)g.A + (size_t)cur.pm * tstep + (size_t)(cur.kq * cur.nt) * kstep; const char* cB = (const char*)g.Bt + (size_t)cur.pn * tstep + (size_t)(cur.kq * cur.nt) * kstep;
    PG8_STAGE(PG8_SB(0, 0), cB, voffB); PG8_STAGE(PG8_SB(0, 1), cB + hstep, voffB); PG8_STAGE(PG8_SA(0, 0), cA, voffA); PG8_STAGE(PG8_SA(0, 1), cA + hstep, voffA);
    if (wr == 1) PG8_BAR;
    PG8_WAIT_V(2); PG8_BAR;
    PG8_STAGE(PG8_SB(1, 0), cB + kstep, voffB); PG8_STAGE(PG8_SA(1, 0), cA + kstep, voffA); PG8_STAGE(PG8_SB(1, 1), cB + hstep + kstep, voffB);
    PG8_WAIT_V(6); PG8_BAR;
    for (;;) {
        const bool has_next = S.next(ui + 1, nxt);
        const char* nA = has_next ? (const char*)g.A + (size_t)nxt.pm * tstep + (size_t)(nxt.kq * nxt.nt) * kstep : cA; const char* nB = has_next ? (const char*)g.Bt + (size_t)nxt.pn * tstep + (size_t)(nxt.kq * nxt.nt) * kstep : cB;
        const int nt = cur.nt;
        int t = 0;
#pragma unroll 1
        for (int seg = 0; seg < (Epi::MIDK ? 3 : 1); ++seg) {
        int tend = nt; if constexpr (Epi::MIDK) tend = E.seg_end(cur, seg);
#pragma unroll 1
        for (; t < tend; t += 2) {
            const bool last = (t == nt - 2);
            const char* a1 = cA + (size_t)(t + 1) * kstep;
            const char* a2 = last ? nA : cA + (size_t)(t + 2) * kstep; const char* b2 = last ? nB : cB + (size_t)(t + 2) * kstep;
            const char* a3 = a2 + kstep; const char* b3 = b2 + kstep;
            PG8_LDB(B0, 0, 0); PG8_LDB(B1, 0, 1); PG8_SCHED; PG8_LDA(At, 0, 0); PG8_STAGE(PG8_SA(1, 1), a1 + hstep, voffA);
            PG8_WAIT_V(8); PG8_WAIT_L(0); PG8_BAR; PG8_MMA(0, 0, At, B0); PG8_MMA(0, 1, At, B1); PG8_BAR; PG8_SCHED;
            PG8_LDA(At, 0, 1); PG8_STAGE(PG8_SB(0, 0), b2, voffB); PG8_STAGE(PG8_SB(0, 1), b2 + hstep, voffB); PG8_STAGE(PG8_SA(0, 0), a2, voffA);
            PG8_WAIT_V(8); PG8_WAIT_L(0); PG8_BAR; PG8_MMA(1, 0, At, B0); PG8_MMA(1, 1, At, B1); PG8_BAR; PG8_SCHED;
            PG8_LDB(B0, 1, 0); PG8_LDB(B1, 1, 1); PG8_SCHED; PG8_LDA(At, 1, 0); PG8_STAGE(PG8_SA(0, 1), a2 + hstep, voffA);
            PG8_WAIT_V(8); PG8_WAIT_L(0); PG8_BAR; PG8_MMA(0, 0, At, B0); PG8_MMA(0, 1, At, B1); PG8_BAR; PG8_SCHED;
            PG8_LDA(At, 1, 1); PG8_STAGE(PG8_SB(1, 0), b3, voffB); PG8_STAGE(PG8_SB(1, 1), b3 + hstep, voffB); PG8_STAGE(PG8_SA(1, 0), a3, voffA);
            PG8_WAIT_V(8); PG8_WAIT_L(0); PG8_BAR; PG8_MMA(1, 0, At, B0); PG8_MMA(1, 1, At, B1); PG8_BAR; PG8_SCHED;
        }
        if constexpr (Epi::MIDK) { if (seg < 2 && tend < nt) E.mid(acc, cur, seg, wr, wc, fr, fq); }
        }
        if (wr == 0) PG8_BAR;
        E(acc, cur, wr, wc, fr, fq);
        if (!has_next) break;
#pragma unroll
        for (int a = 0; a < 2; ++a)
#pragma unroll
            for (int b = 0; b < 2; ++b)
#pragma unroll
                for (int m = 0; m < 4; ++m)
#pragma unroll
                    for (int n = 0; n < 2; ++n) acc[a][b][m][n] = (f32x4){0.f, 0.f, 0.f, 0.f};
        cur = nxt; cA = nA; cB = nB; ++ui;
        if (wr == 1) PG8_BAR;
    }
    PG8_WAIT_V(0);
    PG8_BAR;
#undef PG8_SA
#undef PG8_SB
#undef PG8_STAGE
#undef PG8_LDA
#undef PG8_LDB
#undef PG8_MMA
#undef PG8_WAIT_V
#undef PG8_WAIT_L
#undef PG8_BAR
#undef PG8_SCHED
}

typedef const f32x4 (&AccRef)[2][2][4][2];
__device__ __forceinline__ u32x4 pack8(const float (&v)[8]) { u32x4 w; w.x = cvt_pk_bf16(v[0], v[1]); w.y = cvt_pk_bf16(v[2], v[3]); w.z = cvt_pk_bf16(v[4], v[5]); w.w = cvt_pk_bf16(v[6], v[7]); return w; }

template <int ACT> struct EpiStore {
    static constexpr bool PERM = true, MIDK = false, FP8 = false; static constexpr int MID_T0 = -1, MID_T1 = -1, SCALE_W = 127;
    bf16* O; int ldc;
    __device__ __forceinline__ void operator()(AccRef acc, const Unit& u, int wr, int wc, int fr, int fq) const {
        const int row0 = u.pm * BM + wr * 64 + fr, col0 = u.pn * BM + wc * 32 + 8 * fq;
#pragma unroll
        for (int ai = 0; ai < 2; ++ai)
#pragma unroll
            for (int m = 0; m < 4; ++m) { bf16* rowp = O + (size_t)(row0 + ai * HALF + m * 16) * ldc + col0;
#pragma unroll
                for (int bj = 0; bj < 2; ++bj) { float v[8];
#pragma unroll
                    for (int e = 0; e < 8; ++e) { float x = acc[ai][bj][m][e >> 2][e & 3]; if (ACT == 1) { x = x > 0.f ? x : 0.f; x = x * x; } v[e] = x; }
                    *(u32x4*)(rowp + bj * HALF) = pack8(v); } }
    }
};

struct EpiStoreSplit {
    static constexpr bool PERM = true, MIDK = false, FP8 = false; static constexpr int MID_T0 = -1, MID_T1 = -1, SCALE_W = 127;
    bf16* O; bf16* P;
    __device__ __forceinline__ void operator()(AccRef acc, const Unit& u, int wr, int wc, int fr, int fq) const {
        const int row0 = u.pm * BM + wr * 64 + fr, col0 = u.pn * BM + wc * 32 + 8 * fq;
        bf16* base = (u.pm < 64) ? O + (size_t)row0 * DM + col0 : P + ((size_t)u.kq * MS + (row0 - MP)) * DM + col0;
#pragma unroll
        for (int ai = 0; ai < 2; ++ai)
#pragma unroll
            for (int m = 0; m < 4; ++m) { bf16* rowp = base + (size_t)(ai * HALF + m * 16) * DM;
#pragma unroll
                for (int bj = 0; bj < 2; ++bj) { float v[8];
#pragma unroll
                    for (int e = 0; e < 8; ++e) v[e] = acc[ai][bj][m][e >> 2][e & 3];
                    *(u32x4*)(rowp + bj * HALF) = pack8(v); } }
    }
};

struct EpiMemKV {
    static constexpr bool PERM = true, MIDK = false, FP8 = false; static constexpr int MID_T0 = -1, MID_T1 = -1, SCALE_W = 127;
    bf16* O; float* ok; float* ov;
    __device__ __forceinline__ void operator()(AccRef acc, const Unit& u, int wr, int wc, int fr, int fq) const {
        const int row0 = u.pm * BM + wr * 64 + fr, col0 = u.pn * BM + wc * 32 + 8 * fq;
        float* fo = (u.pn < 4) ? ok : ov; const int fcol0 = col0 & 1023;
#pragma unroll
        for (int ai = 0; ai < 2; ++ai)
#pragma unroll
            for (int m = 0; m < 4; ++m) { const int row = row0 + ai * HALF + m * 16;
#pragma unroll
                for (int bj = 0; bj < 2; ++bj) { float v[8];
#pragma unroll
                    for (int e = 0; e < 8; ++e) v[e] = acc[ai][bj][m][e >> 2][e & 3];
                    *(u32x4*)(O + (size_t)row * 2048 + col0 + bj * HALF) = pack8(v);
                    float* fp = fo + (size_t)row * 1024 + fcol0 + bj * HALF;
                    *(f32x4*)fp = acc[ai][bj][m][0]; *(f32x4*)(fp + 4) = acc[ai][bj][m][1]; } }
    }
};

struct EpiIn {
    static constexpr bool PERM = true, MIDK = false, FP8 = false; static constexpr int MID_T0 = -1, MID_T1 = -1, SCALE_W = 127;
    bf16* Z; float* stats; const float* rope; float* outl; int l;
    template <int MODE> __device__ __forceinline__ void emit(AccRef acc, const Unit& u, int wr, int wc, int fr, int fq) const {
        const bool isk = (u.pn == 18);
        const int row0 = u.pm * BM + wr * 64 + fr, ct = wc * 32 + 8 * fq;
        const bool ropelane = ((wc & 1) == 0) && (fq < 2);
        f32x4 tn[4];
        if (MODE == 2 || MODE == 3) { const int pos = row0 < MP ? (row0 & (SEQ - 1)) : (PAST + ((row0 - MP) & (DS - 1))); const f32x4* rp = (const f32x4*)(rope + (size_t)pos * 16); tn[0] = rp[0]; tn[1] = rp[1]; tn[2] = rp[2]; tn[3] = rp[3]; }
#pragma unroll
        for (int ai = 0; ai < 2; ++ai)
#pragma unroll
            for (int m = 0; m < 4; ++m) {
                const int row = row0 + ai * HALF + m * 16;
                constexpr int CR = (MODE == 0) ? C_U : (MODE == 1) ? C_GV : (MODE == 2) ? C_Q : (MODE == 3) ? C_K : C_CQ, WR = (MODE == 0 || MODE == 1 || MODE == 2) ? 1536 : (MODE == 3) ? ZW_KV : ZW_CQ;
                bf16* zp = Z + (size_t)MT * CR + (size_t)row * WR + (u.pn * BM - CR) + ct;
                float cs[8], sn[8];
                if (MODE == 2 || MODE == 3) {
#pragma unroll
                    for (int e = 0; e < 4; ++e) { cs[e] = tn[0][e]; cs[4 + e] = tn[1][e]; sn[e] = tn[2][e]; sn[4 + e] = tn[3][e]; }
                    if (ai * 4 + m < 7) { const int rown = row0 + ((ai * 4 + m + 1) >> 2) * HALF + ((ai * 4 + m + 1) & 3) * 16;
                        const int pos = rown < MP ? (rown & (SEQ - 1)) : (PAST + ((rown - MP) & (DS - 1))); const f32x4* rp = (const f32x4*)(rope + (size_t)pos * 16); tn[0] = rp[0]; tn[1] = rp[1]; tn[2] = rp[2]; tn[3] = rp[3]; }
                }
                float* fdst = nullptr;
                if (MODE == 3) {
                    if (row < MP) { const int pos = row & (SEQ - 1); if (pos >= SEQ - 128) fdst = outl + (isk ? O_KP : O_VP) + ((size_t)((l * NB + (row >> 12)) * 128 + pos - (SEQ - 128))) * 256 + ct; }
                    else fdst = outl + (isk ? O_KS : O_VS) + ((size_t)l * MS + (row - MP)) * 256 + ct;
                }
                float ssum = 0.f, ssq = 0.f;
#pragma unroll
                for (int bj = 0; bj < 2; ++bj) { float v[8];
#pragma unroll
                    for (int e = 0; e < 8; ++e) v[e] = acc[ai][bj][m][e >> 2][e & 3];
                    if (MODE == 0 || MODE == 1) {
#pragma unroll
                        for (int e = 0; e < 8; ++e) v[e] = gelu_tanh(v[e]);
                    }
                    if (MODE == 1) {
#pragma unroll
                        for (int e = 0; e < 8; ++e) { ssum += v[e]; ssq += v[e] * v[e]; }
                    }
                    if (MODE == 2 || (MODE == 3 && isk)) {
#pragma unroll
                        for (int e = 0; e < 8; ++e) { const float p = __shfl_xor(v[e], 16); const float rv = (fq == 0) ? (v[e] * cs[e] - p * sn[e]) : (v[e] * cs[e] + p * sn[e]); v[e] = ropelane ? rv : v[e]; }
                    }
                    if (MODE == 6) {
                        unsigned q[8];
#pragma unroll
                        for (int e = 0; e < 8; ++e) q[e] = (unsigned)__builtin_rintf(fminf(fmaxf(sigmoidf_(v[e]) * 255.0f, 1.0f), 255.0f));
                        u32x2 w; w.x = q[0] | (q[1] << 8) | (q[2] << 16) | (q[3] << 24); w.y = q[4] | (q[5] << 8) | (q[6] << 16) | (q[7] << 24);
                        *(u32x2*)((unsigned char*)Z + ZO_GATE_B + (size_t)row * ZW_GATE_B + (u.pn - 24) * BM + bj * HALF + ct) = w;
                    } else
                    *(u32x4*)(zp + bj * HALF) = pack8(v);
                    if (MODE == 3) { if (fdst) { *(f32x4*)(fdst + bj * HALF) = (f32x4){v[0], v[1], v[2], v[3]}; *(f32x4*)(fdst + bj * HALF + 4) = (f32x4){v[4], v[5], v[6], v[7]}; } }
                }
                if (MODE == 1) {
                    ssum += __shfl_xor(ssum, 16); ssum += __shfl_xor(ssum, 32); ssq += __shfl_xor(ssq, 16); ssq += __shfl_xor(ssq, 32);
                    if (fq == 0) { typedef float f32x2 __attribute__((ext_vector_type(2))); *(f32x2*)(stats + (((size_t)(u.pn - 6) * MT + row) * 4 + wc) * 2) = (f32x2){ssum, ssq}; }
                }
                asm volatile("" ::: "memory");
            }
    }
    __device__ __forceinline__ void operator()(AccRef acc, const Unit& u, int wr, int wc, int fr, int fq) const {
        const int pn = u.pn;
        if (pn < 6) emit<0>(acc, u, wr, wc, fr, fq);
        else if (pn < 12) emit<1>(acc, u, wr, wc, fr, fq);
        else if (pn < 18) emit<2>(acc, u, wr, wc, fr, fq);
        else if (pn < 20) emit<3>(acc, u, wr, wc, fr, fq);
        else if (pn < 24) emit<5>(acc, u, wr, wc, fr, fq);
        else emit<6>(acc, u, wr, wc, fr, fq);
    }
};

struct EpiGate {
    static constexpr bool PERM = true, MIDK = false, FP8 = true; static constexpr int MID_T0 = -1, MID_T1 = -1, SCALE_W = 127 - 6;
    bf16* Z;
    __device__ __forceinline__ void operator()(AccRef acc, const Unit& u, int wr, int wc, int fr, int fq) const {
        const int row0 = u.pm * BM + wr * 64 + fr, ct = wc * 32 + 8 * fq;
#pragma unroll
        for (int ai = 0; ai < 2; ++ai)
#pragma unroll
            for (int m = 0; m < 4; ++m) { unsigned char* gp = (unsigned char*)Z + ZO_GATE_B + (size_t)(row0 + ai * HALF + m * 16) * ZW_GATE_B + u.pn * BM + ct;
#pragma unroll
                for (int bj = 0; bj < 2; ++bj) { unsigned q[8];
#pragma unroll
                    for (int e = 0; e < 8; ++e) q[e] = (unsigned)fmaxf(__builtin_fmaf(frcp(1.0f + fexp2(acc[ai][bj][m][e >> 2][e & 3] * (-LOG2E / 64.0f))), 255.0f, 0.5f), 1.0f);
                    u32x2 w; w.x = q[0] | (q[1] << 8) | (q[2] << 16) | (q[3] << 24); w.y = q[4] | (q[5] << 8) | (q[6] << 16) | (q[7] << 24);
                    *(u32x2*)(gp + bj * HALF) = w; } }
    }
};

struct EpiMerge {
    static constexpr bool PERM = true, MIDK = true, FP8 = false; static constexpr int MID_T0 = 1536 / BK, MID_T1 = 3072 / BK, SCALE_W = 127;
    const bf16* Z; bf16* O; bf16* P;
    __device__ __forceinline__ int seg_end(const Unit& u, int seg) const {
        if (u.pm < 64) return seg == 0 ? MID_T0 : seg == 1 ? MID_T1 : u.nt;
        return (seg == 0 && u.kq == 1) ? 8 : u.nt;
    }
    static __device__ __forceinline__ float ub(unsigned w, int k) { return (float)((w >> (8 * k)) & 255u); }
    __device__ __forceinline__ void mid(f32x4 (&acc)[2][2][4][2], const Unit& u, int st, int wr, int wc, int fr, int fq) const {
        const int row0 = u.pm * BM + wr * 64 + fr, col0 = u.pn * BM + wc * 32 + 8 * fq;
        const unsigned char* gbase = (const unsigned char*)Z + ZO_GATE_B + (size_t)row0 * ZW_GATE_B + st * DM + col0;
        u32x2 ga[2][4][2], gb[2][4][2];
#pragma unroll
        for (int ai = 0; ai < 2; ++ai)
#pragma unroll
            for (int m = 0; m < 4; ++m) { const unsigned char* gp = gbase + (size_t)(ai * HALF + m * 16) * ZW_GATE_B;
#pragma unroll
                for (int bj = 0; bj < 2; ++bj) { ga[ai][m][bj] = *(const u32x2*)(gp + bj * HALF); gb[ai][m][bj] = *(const u32x2*)(gp + DM + bj * HALF); } }
#pragma unroll
        for (int ai = 0; ai < 2; ++ai)
#pragma unroll
            for (int m = 0; m < 4; ++m)
#pragma unroll
                for (int bj = 0; bj < 2; ++bj)
#pragma unroll
                    for (int e = 0; e < 8; ++e) { const unsigned wa = e < 4 ? ga[ai][m][bj].x : ga[ai][m][bj].y, wb = e < 4 ? gb[ai][m][bj].x : gb[ai][m][bj].y;
                        acc[ai][bj][m][e >> 2][e & 3] *= ub(wa, e & 3) * frcp(fmaxf(ub(wb, e & 3), 1.0f)); }
    }
    __device__ __forceinline__ void operator()(AccRef acc, const Unit& u, int wr, int wc, int fr, int fq) const {
        const int row0 = u.pm * BM + wr * 64 + fr, col0 = u.pn * BM + wc * 32 + 8 * fq;
        const int fg = (u.pm < 64) ? 2 : (u.kq == 0 ? 0 : u.kq == 3 ? 2 : 1);
        bf16* dst = (u.pm < 64) ? O + (size_t)row0 * DM + col0 : P + ((size_t)u.kq * MS + (row0 - MP)) * DM + col0;
#pragma unroll
        for (int ai = 0; ai < 2; ++ai)
#pragma unroll
            for (int m = 0; m < 4; ++m) { const int row = row0 + ai * HALF + m * 16; const unsigned char* gp = (const unsigned char*)Z + ZO_GATE_B + (size_t)row * ZW_GATE_B + fg * DM + col0;
#pragma unroll
                for (int bj = 0; bj < 2; ++bj) { const u32x2 gc = *(const u32x2*)(gp + bj * HALF); float v[8];
#pragma unroll
                    for (int e = 0; e < 8; ++e) v[e] = acc[ai][bj][m][e >> 2][e & 3] * (ub(e < 4 ? gc.x : gc.y, e & 3) * (1.0f / 255.0f));
                    *(u32x4*)(dst + (size_t)(ai * HALF + m * 16) * DM + bj * HALF) = pack8(v); } }
    }
};
}

#define XB_TMO      128
#define XB_XCNT(j)  (256  + 64 * (j))
#define XB_XSUB(j)  (1280 + 64 * (j))
#define XB_XGEN(j)  (2304 + 64 * (j))
#define XB_TOP      3328
#define XB_TOPGEN   3392
#define XCD_BAR_WORDS 3456
#define XB_SPIN_CAP (1u << 18)
__device__ __forceinline__ unsigned xb_ld(unsigned* p)              { return __hip_atomic_load(p, __ATOMIC_RELAXED, __HIP_MEMORY_SCOPE_AGENT); }
__device__ __forceinline__ unsigned xb_add(unsigned* p, unsigned v) { return __hip_atomic_fetch_add(p, v, __ATOMIC_RELAXED, __HIP_MEMORY_SCOPE_AGENT); }
__device__ __forceinline__ unsigned xb_xcc_id() { return (unsigned)__builtin_amdgcn_s_getreg((3 << 11) | 20) & 0xFu; }
#define XB_SPIN(cond, bar) do { unsigned _sp = 0; while (cond) { __builtin_amdgcn_s_sleep(1); \
    if ((++_sp & 255u) == 0u) { if (xb_ld(&(bar)[XB_TMO])) break; if (_sp > XB_SPIN_CAP) { atomicAdd(&(bar)[XB_TMO], 1u); break; } } } } while (0)
struct XcdBarrier { unsigned* bar; unsigned x; volatile LAS unsigned* st; };
__device__ __forceinline__ XcdBarrier xcd_barrier_post(unsigned* bar, volatile LAS unsigned* st) {
    XcdBarrier b; b.bar = bar; b.x = xb_xcc_id(); b.st = st;
    if (threadIdx.x == 0) (void)xb_add(&bar[XB_XCNT(b.x)], 1u);
    return b;
}
__device__ __forceinline__ void xcd_barrier_complete(unsigned* bar, unsigned x, unsigned& nloc, unsigned& nx) {
    const unsigned G = gridDim.x * gridDim.y * gridDim.z;
    unsigned sum, cnt, mine, sp = 0u;
    for (;;) {
        sum = 0u; cnt = 0u; mine = 0u;
#pragma unroll
        for (unsigned j = 0; j < 16; ++j) { const unsigned c = xb_ld(&bar[XB_XCNT(j)]); sum += c; cnt += (c > 0u) ? 1u : 0u; mine = (j == x) ? c : mine; }
        if (sum == G) break;
        __builtin_amdgcn_s_sleep(1);
        if ((++sp & 255u) == 0u) { if (xb_ld(&bar[XB_TMO])) break; if (sp > XB_SPIN_CAP) { atomicAdd(&bar[XB_TMO], 1u); break; } }
    }
    nloc = mine > 0u ? mine : 1u; nx = cnt > 0u ? cnt : 1u;
}
__device__ __forceinline__ void xcd_barrier(const XcdBarrier& b) {
    asm volatile("s_waitcnt vmcnt(0)" ::: "memory");
    __syncthreads();
    if (threadIdx.x == 0) {
        unsigned* bar = b.bar;
        const unsigned bx_ = xb_xcc_id();
        __builtin_amdgcn_s_waitcnt(0);
        unsigned nloc = b.st[0], nx = b.st[1];
        if (nloc == 0u) { xcd_barrier_complete(bar, bx_, nloc, nx); b.st[0] = nloc; b.st[1] = nx; }
        const unsigned old = xb_add(&bar[XB_XSUB(bx_)], 1u);
        const unsigned gen = old / nloc;
        if (old + 1u == (gen + 1u) * nloc) {
            __builtin_amdgcn_fence(__ATOMIC_RELEASE, "agent");
            asm volatile("s_waitcnt vmcnt(0)" ::: "memory");
            const unsigned og = xb_add(&bar[XB_TOP], 1u);
            const unsigned tg = og / nx;
            if (og + 1u == (tg + 1u) * nx) xb_add(&bar[XB_TOPGEN], 1u);
            else XB_SPIN(xb_ld(&bar[XB_TOPGEN]) == tg, bar);
            __builtin_amdgcn_fence(__ATOMIC_ACQUIRE, "agent");
            xb_add(&bar[XB_XGEN(bx_)], 1u);
            asm volatile("s_waitcnt vmcnt(0)" ::: "memory");
        } else {
            XB_SPIN(xb_ld(&bar[XB_XGEN(bx_)]) == gen, bar);
            __builtin_amdgcn_fence(__ATOMIC_ACQUIRE, "agent");
            asm volatile("s_waitcnt vmcnt(0)" ::: "memory");
        }
    }
    __syncthreads();
}

struct Args {
    const float* x_prompt; const float* x_sample; const float* cache_swa_k; const float* cache_swa_v; const float* cache_mem_k; const float* cache_mem_v; const float* mem_prompt;
    const float* w_in; const float* ln_v_g; const float* ln_v_b; const float* w_s; const float* b_s; const float* sinks; const float* mem_norm; const float* w_mem_k; const float* w_mem_v;
    const float* w_pa; const float* w_pb; const float* w_pc; const float* w_o; const float* norm_mix_pre; const float* norm_mix_post; const float* norm_ffn_pre; const float* norm_ffn_post;
    const float* w_up; const float* w_down;
    float* out; unsigned char* ws;
};
#define CAS __attribute__((address_space(4)))
#define ARG_FIELDS(X) X(x_prompt) X(x_sample) X(cache_swa_k) X(cache_swa_v) X(cache_mem_k) X(cache_mem_v) X(mem_prompt) X(w_in) X(ln_v_g) X(ln_v_b) X(w_s) X(b_s) X(sinks) X(mem_norm) X(w_mem_k) X(w_mem_v) \
    X(w_pa) X(w_pb) X(w_pc) X(w_o) X(norm_mix_pre) X(norm_mix_post) X(norm_ffn_pre) X(norm_ffn_post) X(w_up) X(w_down) X(out) X(ws)
__device__ __forceinline__ void load_args(Args& L) {
    const CAS Args* p = (const CAS Args*)__builtin_amdgcn_kernarg_segment_ptr();
    asm volatile("" : "+s"(p));
#define CP_(f) L.f = p->f;
    ARG_FIELDS(CP_)
#undef CP_
}
struct Frame {
    LAS unsigned char* lds; volatile LAS unsigned* MISC; gu32* ctl;
    int tid, lane, wave, vcu, G;
};
__device__ __forceinline__ float wave_sum(float v) {
#pragma unroll
    for (int o = 1; o < 64; o <<= 1) v += __shfl_xor(v, o);
    return v;
}

__device__ __forceinline__ void transpose_item(const float* W, int ldw, bf16* WT, int ldk, LAS float* scr, int k0, int n0, int lane) {
    { float v[32];
#pragma unroll
      for (int i = 0; i < 32; ++i) v[i] = W[(size_t)(k0 + 2 * i + (lane >> 5)) * ldw + n0 + (lane & 31)];
#pragma unroll
      for (int i = 0; i < 32; ++i) scr[(2 * i + (lane >> 5)) * 33 + (lane & 31)] = v[i]; }
    LDS_WAIT(); asm volatile("" ::: "memory");
    const int c = lane & 7;
#pragma unroll
    for (int j = 0; j < 4; ++j) { const int n = (lane >> 3) + 8 * j; const LAS float* s = scr + (8 * c) * 33 + n;
        u32x4 o; o.x = cvt_pk_asm(s[0 * 33], s[1 * 33]); o.y = cvt_pk_asm(s[2 * 33], s[3 * 33]); o.z = cvt_pk_asm(s[4 * 33], s[5 * 33]); o.w = cvt_pk_asm(s[6 * 33], s[7 * 33]);
        *(u32x4*)(WT + (size_t)(n0 + n) * ldk + k0 + 8 * c) = o; }
    LDS_WAIT(); asm volatile("" ::: "memory");
}
__device__ __forceinline__ void transpose_item_fp8(const float* W, int ldw, unsigned char* WT8, int ldk, LAS float* scr, int k0, int n0, int lane, float sc) {
    { float v[32];
#pragma unroll
      for (int i = 0; i < 32; ++i) v[i] = W[(size_t)(k0 + 2 * i + (lane >> 5)) * ldw + n0 + (lane & 31)];
#pragma unroll
      for (int i = 0; i < 32; ++i) scr[(2 * i + (lane >> 5)) * 33 + (lane & 31)] = v[i] * sc; }
    LDS_WAIT(); asm volatile("" ::: "memory");
    const int c = lane & 7;
#pragma unroll
    for (int j = 0; j < 4; ++j) { const int n = (lane >> 3) + 8 * j; const LAS float* s = scr + (8 * c) * 33 + n;
        int lo = 0, hi = 0;
        lo = __builtin_amdgcn_cvt_pk_fp8_f32(s[0 * 33], s[1 * 33], lo, false); lo = __builtin_amdgcn_cvt_pk_fp8_f32(s[2 * 33], s[3 * 33], lo, true);
        hi = __builtin_amdgcn_cvt_pk_fp8_f32(s[4 * 33], s[5 * 33], hi, false); hi = __builtin_amdgcn_cvt_pk_fp8_f32(s[6 * 33], s[7 * 33], hi, true);
        *(u32x2*)(WT8 + (size_t)(n0 + n) * ldk + k0 + 8 * c) = (u32x2){(unsigned)lo, (unsigned)hi}; }
    LDS_WAIT(); asm volatile("" ::: "memory");
}
__device__ __forceinline__ bool conv_mat(int& r, const float* W, int K, int N, bf16* WT, int ldk, LAS float* scr, int lane) {
    const int nblk = N / 32, items = (K / 64) * nblk;
    if (r < items) { const int kb = r / nblk, nb = r - kb * nblk; transpose_item(W, N, WT, ldk, scr, 64 * kb, 32 * nb, lane); return true; }
    r -= items; return false;
}
constexpr int CONV_ITEMS_PER_LAYER = 32 * 384 + 24 * 64 * 2 + 16 * 64 + 32 * 64 + 32 * 256 + 128 * 64 + 32 * 32 * 2;

__device__ __forceinline__ void convert_layer(Frame& F, const Args& A, int l, int worker, int nworkers) {
    LAS float* scr = (LAS float*)(F.lds + F.wave * 16384);
    const int gw = worker * 8 + F.wave, NGW = nworkers * 8;
    for (int it = gw; it < CONV_ITEMS_PER_LAYER; it += NGW) {
        int r = it;
        unsigned char* wl = A.ws + WS_W + (size_t)l * W_LAYER;
        { const int nblk = C_G / 32, items = (DM / 64) * nblk;
          if (r < items) { const int kb = r / nblk, nb = r - kb * nblk; transpose_item(A.w_in + (size_t)l * DM * INW, INW, (bf16*)(wl + W_IN), DM, scr, 64 * kb, 32 * nb, F.lane); continue; } r -= items;
          if (r < items) { const int kb = r / nblk, nb = r - kb * nblk; transpose_item_fp8(A.w_in + (size_t)l * DM * INW + C_G, INW, wl + W_G8, DM, scr, 64 * kb, 32 * nb, F.lane, 64.0f); continue; } r -= items; }
        if (conv_mat(r, A.w_pa + (size_t)l * GW * DM, GW, DM, (bf16*)(wl + W_MG), OCW, scr, F.lane)) continue;
        if (conv_mat(r, A.w_pb + (size_t)l * GW * DM, GW, DM, (bf16*)(wl + W_MG) + 1536, OCW, scr, F.lane)) continue;
        if (conv_mat(r, A.w_pc + (size_t)l * 1024 * DM, 1024, DM, (bf16*)(wl + W_MG) + 3072, OCW, scr, F.lane)) continue;
        if (conv_mat(r, A.w_o + (size_t)l * DM * DM, DM, DM, (bf16*)(wl + W_O), DM, scr, F.lane)) continue;
        if (conv_mat(r, A.w_up + (size_t)l * DM * FF, DM, FF, (bf16*)(wl + W_UP), DM, scr, F.lane)) continue;
        if (conv_mat(r, A.w_down + (size_t)l * FF * DM, FF, DM, (bf16*)(wl + W_DN), FF, scr, F.lane)) continue;
        if (conv_mat(r, A.w_mem_k + (size_t)l * DM * 1024, DM, 1024, (bf16*)(wl + W_MEM), DM, scr, F.lane)) continue;
        conv_mat(r, A.w_mem_v + (size_t)l * DM * 1024, DM, 1024, (bf16*)(wl + W_MEM) + (size_t)1024 * DM, DM, scr, F.lane);
    }
}
__device__ __forceinline__ void p0_tables(Frame& F, const Args& A) {
    const int gt = (F.vcu * 8 + F.wave) * 64 + F.lane, NGT = F.G * 512;
    float* rope = (float*)(A.ws + WS_ROPE);
    for (int i = gt; i < SEQ * 8; i += NGT) {
        const int pos = i >> 3, k = i & 7;
        const double inv = (k == 0) ? 1.0 : (k == 1) ? 0.19392274474868576 : (k == 2) ? 0.03760603093086393 : (k == 3) ? 0.007292664737217109 : (k == 4) ? 0.001414213562373095
                         : (k == 5) ? 0.0002742481756762073 : (k == 6) ? 5.318295896944988e-05 : 1.031338537721246e-05;
        const double ang = (double)pos * inv;
        const double n = __builtin_rint(ang * 0.15915494309189535);
        double rr = __builtin_fma(-n, 6.283185307179586, ang); rr = __builtin_fma(-n, 2.4492935982947064e-16, rr);
        const double r2 = rr * rr;
        double sc = 1.0, ss = 1.0;
        double tc = 1.0, ts = 1.0;
#pragma unroll 1
        for (int j = 1; j <= 16; ++j) { tc *= -r2 / (double)((2 * j - 1) * (2 * j)); ts *= -r2 / (double)((2 * j) * (2 * j + 1)); sc += tc; ss += ts; }
        rope[pos * 16 + k] = (float)sc; rope[pos * 16 + 8 + k] = (float)(ss * rr);
    }
    bf16* wsb = (bf16*)(A.ws + WS_WS);
    for (int i = gt; i < DEPTH * 12 * 128 * 128 / 4; i += NGT) {
        const int e = i * 4, col = e & 127, row = (e >> 7) & 127;
        const f32x4 w = *(const f32x4*)(A.w_s + e);
        u32x2 o; o.x = cvt_pk_asm(col <= row ? w.x : 0.f, col + 1 <= row ? w.y : 0.f); o.y = cvt_pk_asm(col + 2 <= row ? w.z : 0.f, col + 3 <= row ? w.w : 0.f);
        *(u32x2*)(wsb + e) = o;
    }
}
__device__ __forceinline__ void p0_rows(Frame& F, const Args& A) {
    const int gw = F.vcu * 8 + F.wave, NGW = F.G * 8;
    for (int m = gw; m < 1024; m += NGW) {
        const f32x4* xr = (const f32x4*)(A.mem_prompt + (size_t)m * DM) + F.lane;
        f32x4 v[8]; float s = 0.f;
#pragma unroll
        for (int j = 0; j < 8; ++j) { v[j] = xr[64 * j]; s += (v[j].x * v[j].x + v[j].y * v[j].y) + (v[j].z * v[j].z + v[j].w * v[j].w); }
        const float rstd = 1.0f / sqrtf(wave_sum(s) * (1.f / DM) + EPS);
#pragma unroll 1
        for (int l = 0; l < DEPTH; ++l) {
            const f32x4* gp = (const f32x4*)(A.mem_norm + (size_t)l * DM) + F.lane;
            u32x2* o = (u32x2*)((bf16*)(A.ws + WS_MN) + ((size_t)l * 1024 + m) * DM) + F.lane;
#pragma unroll
            for (int j = 0; j < 8; ++j) { const f32x4 g = gp[64 * j]; u32x2 w; w.x = cvt_pk_asm(v[j].x * rstd * g.x, v[j].y * rstd * g.y); w.y = cvt_pk_asm(v[j].z * rstd * g.z, v[j].w * rstd * g.w); o[64 * j] = w; }
        }
    }
    f32x4 g0[8];
#pragma unroll
    for (int j = 0; j < 8; ++j) g0[j] = ((const f32x4*)A.norm_mix_pre + F.lane)[64 * j];
    for (int m = gw; m < MT; m += NGW) {
        const float* src = m < MP ? A.x_prompt + (size_t)m * DM : A.x_sample + (size_t)(m - MP) * DM;
        const f32x4* xr = (const f32x4*)src + F.lane;
        f32x4 v[8]; float s = 0.f;
#pragma unroll
        for (int j = 0; j < 8; ++j) { v[j] = xr[64 * j]; s += (v[j].x * v[j].x + v[j].y * v[j].y) + (v[j].z * v[j].z + v[j].w * v[j].w); }
        const float rstd = 1.0f / sqrtf(wave_sum(s) * (1.f / DM) + EPS);
        u32x2* o = (u32x2*)((bf16*)(A.ws + WS_H) + (size_t)m * DM) + F.lane;
#pragma unroll
        for (int j = 0; j < 8; ++j) { u32x2 w; w.x = cvt_pk_asm(v[j].x * rstd * g0[j].x, v[j].y * rstd * g0[j].y); w.y = cvt_pk_asm(v[j].z * rstd * g0[j].z, v[j].w * rstd * g0[j].w); o[64 * j] = w; }
        unsigned* o8 = (unsigned*)(A.ws + WS_H8 + (size_t)m * DM) + F.lane;
#pragma unroll
        for (int j = 0; j < 8; ++j) { int w8 = 0; w8 = __builtin_amdgcn_cvt_pk_fp8_f32(v[j].x * rstd * g0[j].x, v[j].y * rstd * g0[j].y, w8, false); w8 = __builtin_amdgcn_cvt_pk_fp8_f32(v[j].z * rstd * g0[j].z, v[j].w * rstd * g0[j].w, w8, true); o8[64 * j] = (unsigned)w8; }
    }
}
__device__ __forceinline__ void thin_phase(Frame& F, const Args& A, const bf16* D, const bf16* PART, const float* gpost, const float* gnext, const float* gprev, bool first, bool last, bool h8) {
    const int gw = F.vcu * 8 + F.wave, NGW = F.G * 8;
    int lane = F.lane; asm volatile("" : "+v"(lane));
    f32x4 gp[8], gn[8], gi[8];
#pragma unroll
    for (int j = 0; j < 8; ++j) { gp[j] = ((const f32x4*)gpost + lane)[64 * j]; gn[j] = gnext ? ((const f32x4*)gnext + lane)[64 * j] : (f32x4){0.f, 0.f, 0.f, 0.f};
        const f32x4 gv = first ? (f32x4){1.f, 1.f, 1.f, 1.f} : ((const f32x4*)gprev + lane)[64 * j]; gi[j] = (f32x4){1.0f / gv.x, 1.0f / gv.y, 1.0f / gv.z, 1.0f / gv.w}; }
    bf16* const HB = (bf16*)(A.ws + WS_H); float* const SIG = (float*)(A.ws + WS_SIG);
    for (int m = gw; m < MT; m += NGW) {
        f32x4 d[8], x[8]; float s = 0.f;
        if (m < MP) {
            const u32x2* dr = (const u32x2*)(D + (size_t)m * DM) + lane;
#pragma unroll
            for (int j = 0; j < 8; ++j) { const u32x2 w = dr[64 * j]; d[j] = (f32x4){bf_lo(w.x), bf_hi(w.x), bf_lo(w.y), bf_hi(w.y)}; }
        } else {
            const u32x2* dr = (const u32x2*)(PART + (size_t)(m - MP) * DM) + lane;
#pragma unroll
            for (int j = 0; j < 8; ++j) { const u32x2 w0 = dr[64 * j], w1 = dr[64 * j + (size_t)MS * DM / 4], w2 = dr[64 * j + 2 * ((size_t)MS * DM / 4)], w3 = dr[64 * j + 3 * ((size_t)MS * DM / 4)];
                d[j] = (f32x4){(bf_lo(w0.x) + bf_lo(w1.x)) + (bf_lo(w2.x) + bf_lo(w3.x)), (bf_hi(w0.x) + bf_hi(w1.x)) + (bf_hi(w2.x) + bf_hi(w3.x)),
                               (bf_lo(w0.y) + bf_lo(w1.y)) + (bf_lo(w2.y) + bf_lo(w3.y)), (bf_hi(w0.y) + bf_hi(w1.y)) + (bf_hi(w2.y) + bf_hi(w3.y))}; }
        }
        if (first) {
            const f32x4* xs = (const f32x4*)(m < MP ? A.x_prompt + (size_t)m * DM : A.x_sample + (size_t)(m - MP) * DM) + lane;
#pragma unroll
            for (int j = 0; j < 8; ++j) x[j] = xs[64 * j];
        } else {
            const u32x2* xs = (const u32x2*)(HB + (size_t)m * DM) + lane; const float sg = SIG[m];
#pragma unroll
            for (int j = 0; j < 8; ++j) { const u32x2 w = xs[64 * j]; x[j] = (f32x4){bf_lo(w.x) * sg * gi[j].x, bf_hi(w.x) * sg * gi[j].y, bf_lo(w.y) * sg * gi[j].z, bf_hi(w.y) * sg * gi[j].w}; }
        }
#pragma unroll
        for (int j = 0; j < 8; ++j) s += (d[j].x * d[j].x + d[j].y * d[j].y) + (d[j].z * d[j].z + d[j].w * d[j].w);
        const float rstd = 1.0f / sqrtf(wave_sum(s) * (1.f / DM) + EPS);
        float s2 = 0.f;
#pragma unroll
        for (int j = 0; j < 8; ++j) { x[j] = x[j] + d[j] * rstd * gp[j]; s2 += (x[j].x * x[j].x + x[j].y * x[j].y) + (x[j].z * x[j].z + x[j].w * x[j].w); }
        if (last) {
            f32x4* xo = (f32x4*)(A.out + O_Y + (size_t)m * DM) + lane;
#pragma unroll
            for (int j = 0; j < 8; ++j) xo[64 * j] = x[j];
        }
        if (gnext) {
            const float sig2 = sqrtf(wave_sum(s2) * (1.f / DM) + EPS), rstd2 = 1.0f / sig2;
            if (lane == 0) SIG[m] = sig2;
            u32x2* o = (u32x2*)(HB + (size_t)m * DM) + lane;
#pragma unroll
            for (int j = 0; j < 8; ++j) { u32x2 w; w.x = cvt_pk_asm(x[j].x * rstd2 * gn[j].x, x[j].y * rstd2 * gn[j].y); w.y = cvt_pk_asm(x[j].z * rstd2 * gn[j].z, x[j].w * rstd2 * gn[j].w); o[64 * j] = w; }
            if (h8) {
                unsigned* o8 = (unsigned*)(A.ws + WS_H8 + (size_t)m * DM) + lane;
#pragma unroll
                for (int j = 0; j < 8; ++j) { int w8 = 0; w8 = __builtin_amdgcn_cvt_pk_fp8_f32(x[j].x * rstd2 * gn[j].x, x[j].y * rstd2 * gn[j].y, w8, false); w8 = __builtin_amdgcn_cvt_pk_fp8_f32(x[j].z * rstd2 * gn[j].z, x[j].w * rstd2 * gn[j].w, w8, true); o8[64 * j] = (unsigned)w8; }
            }
        }
    }
}

__device__ __forceinline__ bf16x8 pack_p(const f32x16& p, int s) {
    u32x4 w; w.x = cvt_pk_asm(p[8 * s + 0], p[8 * s + 1]); w.y = cvt_pk_asm(p[8 * s + 2], p[8 * s + 3]); w.z = cvt_pk_asm(p[8 * s + 4], p[8 * s + 5]); w.w = cvt_pk_asm(p[8 * s + 6], p[8 * s + 7]);
    return __builtin_bit_cast(bf16x8, w);
}
__device__ __forceinline__ u32x4 ld_f32x8_as_bf16(const float* p) { const f32x4 a = *(const f32x4*)p, b = *(const f32x4*)(p + 4); u32x4 w; w.x = cvt_pk_asm(a.x, a.y); w.y = cvt_pk_asm(a.z, a.w); w.z = cvt_pk_asm(b.x, b.y); w.w = cvt_pk_asm(b.z, b.w); return w; }
__device__ __forceinline__ void scatter8(LAS bf16* base, int pitch, u32x4 w) {
    base[0 * pitch] = (bf16)(w.x & 0xffffu); base[1 * pitch] = (bf16)(w.x >> 16); base[2 * pitch] = (bf16)(w.y & 0xffffu); base[3 * pitch] = (bf16)(w.y >> 16);
    base[4 * pitch] = (bf16)(w.z & 0xffffu); base[5 * pitch] = (bf16)(w.z >> 16); base[6 * pitch] = (bf16)(w.w & 0xffffu); base[7 * pitch] = (bf16)(w.w >> 16);
}
__device__ __forceinline__ bf16x8 ld_vt(const LAS bf16* vp) {
    const s16x4 lo = *(const LAS s16x4*)vp, hi = *(const LAS s16x4*)(vp + 8);
    return (bf16x8){lo[0], lo[1], lo[2], lo[3], hi[0], hi[1], hi[2], hi[3]};
}

typedef short v4i16_t __attribute__((ext_vector_type(4)));
__device__ __forceinline__ s16x4 vtr(const LAS bf16* p) { return __builtin_bit_cast(s16x4, __builtin_amdgcn_ds_read_tr16_b64_v4i16((LAS v4i16_t*)p)); }
__device__ __forceinline__ bf16x8 ld_tr(const LAS bf16* p, int step) { const s16x4 lo = vtr(p), hi = vtr(p + step); return (bf16x8){lo[0], lo[1], lo[2], lo[3], hi[0], hi[1], hi[2], hi[3]}; }

constexpr int SWA_KP = 72, SWA_VP = 96;
__device__ __forceinline__ void swa_unit(Frame& F, const Args& A, int l, int unit) {
    LAS bf16* Kl = (LAS bf16*)F.lds; LAS bf16* Vl = (LAS bf16*)(F.lds + 192 * SWA_KP * 2);
    const bf16* Z = (const bf16*)(A.ws + WS_Z); bf16* OC = (bf16*)(A.ws + WS_OC);
    const bool samp = unit >= 1024;
    int b, c, kvh;
    if (!samp) { b = unit >> 8; c = (unit >> 2) & 63; kvh = unit & 3; } else { const int u2 = unit - 1024; b = u2 >> 2; c = 2; kvh = u2 & 3; }
    const size_t qrow0 = samp ? (size_t)(MP + b * 64) : (size_t)(b * SEQ + c * 64);
    const int r = F.lane & 31, h = F.lane >> 5;
    bf16x8 qf[2][4]; float sks[2];
#pragma unroll
    for (int ti = 0; ti < 2; ++ti) { const int task = F.wave + 8 * ti; const int tk = task < 12 ? task : 0;
        sks[ti] = A.sinks[l * 24 + kvh * 6 + (tk >> 1)] * LOG2E;
        const bf16* qp = Z + ZO_Q + (qrow0 + (tk & 1) * 32 + r) * ZW_Q + (kvh * 6 + (tk >> 1)) * 64 + h * 8;
#pragma unroll
        for (int ks = 0; ks < 4; ++ks) qf[ti][ks] = *(const bf16x8*)(qp + ks * 16); }
    if (!samp) {
        u32x4 kw[3], vw[3];
#pragma unroll
        for (int i = 0; i < 3; ++i) { const int id = F.tid + 512 * i, kr = id >> 3, cc = id & 7; const int pos = (c - 2) * 64 + kr, posc = pos < 0 ? 0 : pos;
            const bf16* zr = Z + ZO_KV + (size_t)(b * SEQ + posc) * ZW_KV + kvh * 64 + cc * 8; kw[i] = *(const u32x4*)zr; vw[i] = *(const u32x4*)(zr + 256); }
#pragma unroll
        for (int i = 0; i < 3; ++i) { const int id = F.tid + 512 * i, kr = id >> 3, cc = id & 7; const bool ok = (c - 2) * 64 + kr >= 0;
            *(LAS u32x4*)(Kl + kr * SWA_KP + cc * 8) = ok ? kw[i] : (u32x4){0u, 0u, 0u, 0u};
            *(LAS u32x4*)(Vl + kr * SWA_VP + cc * 8) = ok ? vw[i] : (u32x4){0u, 0u, 0u, 0u}; }
    } else {
        f32x4 ka[2][2], va[2][2]; u32x4 kz, vz;
#pragma unroll
        for (int i = 0; i < 2; ++i) { const int id = F.tid + 512 * i, kr = id >> 3, cc = id & 7; const size_t off = ((((size_t)l * DB + b) * 128 + kr) * 4 + kvh) * 64 + cc * 8;
            ka[i][0] = *(const f32x4*)(A.cache_swa_k + off); ka[i][1] = *(const f32x4*)(A.cache_swa_k + off + 4); va[i][0] = *(const f32x4*)(A.cache_swa_v + off); va[i][1] = *(const f32x4*)(A.cache_swa_v + off + 4); }
        { const int id = F.tid + 1024, kr = id >> 3, cc = id & 7; const bf16* zr = Z + ZO_KV + (size_t)(MP + b * 64 + kr - 128) * ZW_KV + kvh * 64 + cc * 8; kz = *(const u32x4*)zr; vz = *(const u32x4*)(zr + 256);
          *(LAS u32x4*)(Kl + kr * SWA_KP + cc * 8) = kz; *(LAS u32x4*)(Vl + kr * SWA_VP + cc * 8) = vz; }
#pragma unroll
        for (int i = 0; i < 2; ++i) { const int id = F.tid + 512 * i, kr = id >> 3, cc = id & 7; u32x4 kw, vw;
            kw.x = cvt_pk_bf16(ka[i][0].x, ka[i][0].y); kw.y = cvt_pk_bf16(ka[i][0].z, ka[i][0].w); kw.z = cvt_pk_bf16(ka[i][1].x, ka[i][1].y); kw.w = cvt_pk_bf16(ka[i][1].z, ka[i][1].w);
            vw.x = cvt_pk_bf16(va[i][0].x, va[i][0].y); vw.y = cvt_pk_bf16(va[i][0].z, va[i][0].w); vw.z = cvt_pk_bf16(va[i][1].x, va[i][1].y); vw.w = cvt_pk_bf16(va[i][1].z, va[i][1].w);
            *(LAS u32x4*)(Kl + kr * SWA_KP + cc * 8) = kw; *(LAS u32x4*)(Vl + kr * SWA_VP + cc * 8) = vw; }
    }
    __syncthreads();
    const int kb0 = samp ? 0 : (c >= 2 ? 0 : 2 * (2 - c));
    const LAS bf16* vlane = Vl + (4 * h + ((F.lane & 15) >> 2)) * SWA_VP + 16 * ((F.lane >> 4) & 1) + 4 * (F.lane & 3);
#pragma unroll
    for (int ti = 0; ti < 2; ++ti) {
        const int task = F.wave + 8 * ti;
        if (task < 12) {
        const int g = task >> 1, hf = task & 1, head = kvh * 6 + g;
        const size_t qrow = qrow0 + hf * 32 + r;
        f32x16 S[6];
#pragma unroll
        for (int blk = 0; blk < 6; ++blk) {
            S[blk] = (f32x16){0.f, 0.f, 0.f, 0.f, 0.f, 0.f, 0.f, 0.f, 0.f, 0.f, 0.f, 0.f, 0.f, 0.f, 0.f, 0.f};
#pragma unroll
            for (int ks = 0; ks < 4; ++ks) { const bf16x8 kf = *(const LAS bf16x8*)(Kl + (blk * 32 + r) * SWA_KP + ks * 16 + h * 8); S[blk] = __builtin_amdgcn_mfma_f32_32x32x16_bf16(kf, qf[ti][ks], S[blk], 0, 0, 0); }
        }
        const float c2 = 0.125f * LOG2E;
        float mx = -3.0e38f;
#pragma unroll
        for (int blk = 0; blk < 6; ++blk)
#pragma unroll
            for (int e = 0; e < 16; ++e) { const float v = (blk < kb0) ? -1.0e30f : S[blk][e]; S[blk][e] = v; mx = fmaxf(mx, v); }
        mx = fmaxf(mx, __shfl_xor(mx, 32));
        const float sk = sks[ti];
        const float m2 = fmaxf(mx * c2, sk);
        float sum = 0.f;
#pragma unroll
        for (int blk = 0; blk < 6; ++blk)
#pragma unroll
            for (int e = 0; e < 16; ++e) { const float p = fexp2(S[blk][e] * c2 - m2); S[blk][e] = p; sum += p; }
        sum += __shfl_xor(sum, 32);
        sum += fexp2(sk - m2);
        const float inv = 1.0f / sum;
        bf16x8 pf[6][2];
#pragma unroll
        for (int blk = 0; blk < 6; ++blk) { pf[blk][0] = pack_p(S[blk], 0); pf[blk][1] = pack_p(S[blk], 1); }
        bf16* op = OC + qrow * OCW + GW + head * 64;
#pragma unroll
        for (int dblk = 0; dblk < 2; ++dblk) {
            f32x16 O = (f32x16){0.f, 0.f, 0.f, 0.f, 0.f, 0.f, 0.f, 0.f, 0.f, 0.f, 0.f, 0.f, 0.f, 0.f, 0.f, 0.f};
#pragma unroll
            for (int blk = 0; blk < 6; ++blk)
#pragma unroll
                for (int s = 0; s < 2; ++s) { const bf16x8 vf = ld_tr(vlane + (blk * 32 + s * 16) * SWA_VP + dblk * 32, 8 * SWA_VP); O = __builtin_amdgcn_mfma_f32_32x32x16_bf16(vf, pf[blk][s], O, 0, 0, 0); }
#pragma unroll
            for (int rg = 0; rg < 4; ++rg) { u32x2 w; w.x = cvt_pk_asm(O[4 * rg] * inv, O[4 * rg + 1] * inv); w.y = cvt_pk_asm(O[4 * rg + 2] * inv, O[4 * rg + 3] * inv);
                *(u32x2*)(op + dblk * 32 + 8 * rg + 4 * h) = w; }
        }
        }
    }
}

constexpr int MEM_KP = 264, MEM_VP = 96;
template <bool samp> __device__ __forceinline__ void mem_unit_t(Frame& F, const Args& A, int l, int unit) {
    LAS bf16* Kc = (LAS bf16*)F.lds;
    const bf16* Z = (const bf16*)(A.ws + WS_Z); bf16* OC = (bf16*)(A.ws + WS_OC);
    int b, hd, qb;
    if (!samp) { b = unit >> 6; hd = (unit >> 4) & 3; qb = unit & 15; } else { const int u2 = unit - 256; b = u2 >> 2; hd = u2 & 3; qb = 0; }
    const size_t qrow0 = samp ? (size_t)(MP + b * 64) : (size_t)(b * SEQ + qb * 256);
    const bool active = samp ? (F.wave < 2) : true;
    int tidv = F.tid, lanev = F.lane;
    int r = lanev & 31, h = lanev >> 5;
    const size_t qrow = qrow0 + (active ? F.wave * 32 : 0) + r;
    const bf16* mkv = (const bf16*)(A.ws + WS_MKV) + ((size_t)l * 1024 + b * 256) * 2048 + hd * 256;
    const size_t coff = (((size_t)l * DB + b) * 256 * 4 + hd) * 256;
    bf16x8 qf[16];
    { const bf16* qp = Z + ZO_CQ + qrow * ZW_CQ + hd * 256 + h * 8;
#pragma unroll
      for (int ks = 0; ks < 16; ++ks) qf[ks] = *(const bf16x8*)(qp + ks * 16); }
    f32x4 ra[4], rb[4];
#define MEM_LOADK(ch) do { _Pragma("unroll") for (int i_ = 0; i_ < 4; ++i_) { const int id_ = tidv + 512 * i_, m_ = (ch) * 64 + (id_ >> 5), cc_ = id_ & 31; \
        if (!samp) ra[i_] = *(const f32x4*)(mkv + (size_t)m_ * 2048 + cc_ * 8); else { const float* p_ = A.cache_mem_k + coff + (size_t)m_ * 1024 + cc_ * 8; ra[i_] = *(const f32x4*)p_; rb[i_] = *(const f32x4*)(p_ + 4); } } } while (0)
#define MEM_LOADV(dc) do { _Pragma("unroll") for (int i_ = 0; i_ < 4; ++i_) { const int id_ = tidv + 512 * i_, m_ = id_ >> 3, cc_ = id_ & 7; \
        if (!samp) ra[i_] = *(const f32x4*)(mkv + (size_t)m_ * 2048 + 1024 + (dc) * 64 + cc_ * 8); else { const float* p_ = A.cache_mem_v + coff + (size_t)m_ * 1024 + (dc) * 64 + cc_ * 8; ra[i_] = *(const f32x4*)p_; rb[i_] = *(const f32x4*)(p_ + 4); } } } while (0)
#define MEM_STG(i_) (samp ? (u32x4){cvt_pk_bf16(ra[i_].x, ra[i_].y), cvt_pk_bf16(ra[i_].z, ra[i_].w), cvt_pk_bf16(rb[i_].x, rb[i_].y), cvt_pk_bf16(rb[i_].z, rb[i_].w)} : __builtin_bit_cast(u32x4, ra[i_]))
    MEM_LOADK(0);
    f32x16 S[8];
#pragma unroll
    for (int ch = 0; ch < 4; ++ch) {
        __syncthreads();
#pragma unroll
        for (int i = 0; i < 4; ++i) { const int id = tidv + 512 * i, mr = id >> 5, cc = id & 31; *(LAS u32x4*)(Kc + mr * MEM_KP + cc * 8) = MEM_STG(i); }
        __syncthreads();
        if (ch < 3) MEM_LOADK(ch + 1); else MEM_LOADV(0);
        if (active) {
#pragma unroll
            for (int blk = 0; blk < 2; ++blk) {
                f32x16 s = (f32x16){0.f, 0.f, 0.f, 0.f, 0.f, 0.f, 0.f, 0.f, 0.f, 0.f, 0.f, 0.f, 0.f, 0.f, 0.f, 0.f};
#pragma unroll
                for (int ks = 0; ks < 16; ++ks) { const bf16x8 kf = *(const LAS bf16x8*)(Kc + (blk * 32 + r) * MEM_KP + ks * 16 + h * 8); s = __builtin_amdgcn_mfma_f32_32x32x16_bf16(kf, qf[ks], s, 0, 0, 0); }
                S[ch * 2 + blk] = s;
            }
        } else {
#pragma unroll
            for (int blk = 0; blk < 2; ++blk) S[ch * 2 + blk] = (f32x16){0.f, 0.f, 0.f, 0.f, 0.f, 0.f, 0.f, 0.f, 0.f, 0.f, 0.f, 0.f, 0.f, 0.f, 0.f, 0.f};
        }
    }
    const float c2 = 0.0625f * LOG2E;
    float mx = -3.0e38f;
#pragma unroll
    for (int blk = 0; blk < 8; ++blk)
#pragma unroll
        for (int e = 0; e < 16; ++e) mx = fmaxf(mx, S[blk][e]);
    mx = fmaxf(mx, __shfl_xor(mx, 32));
    const float m2 = mx * c2;
    float sum = 0.f;
#pragma unroll
    for (int blk = 0; blk < 8; ++blk)
#pragma unroll
        for (int e = 0; e < 16; ++e) { const float p = fexp2(S[blk][e] * c2 - m2); S[blk][e] = p; sum += p; }
    sum += __shfl_xor(sum, 32);
    const float inv = 1.0f / sum;
    bf16x8 pf[8][2];
#pragma unroll
    for (int blk = 0; blk < 8; ++blk) { pf[blk][0] = pack_p(S[blk], 0); pf[blk][1] = pack_p(S[blk], 1); }
    tidv = F.wave * 64 + lane_id(); asm volatile("" : "+v"(tidv)); lanev = tidv & 63; r = lanev & 31; h = lanev >> 5;
    bf16* op = OC + (qrow0 + (active ? F.wave * 32 : 0) + r) * OCW + 3072 + hd * 256;
    const LAS bf16* vlane = Kc + (4 * h + ((lanev & 15) >> 2)) * MEM_VP + 16 * ((lanev >> 4) & 1) + 4 * (lanev & 3);
#pragma unroll 1
    for (int dc = 0; dc < 4; ++dc) {
        __syncthreads();
#pragma unroll
        for (int i = 0; i < 4; ++i) { const int id = tidv + 512 * i, m = id >> 3, cc = id & 7; *(LAS u32x4*)(Kc + m * MEM_VP + cc * 8) = MEM_STG(i); }
        __syncthreads();
        if (dc < 3) MEM_LOADV(dc + 1);
        if (active) {
#pragma unroll
            for (int dblk = 0; dblk < 2; ++dblk) {
                f32x16 O = (f32x16){0.f, 0.f, 0.f, 0.f, 0.f, 0.f, 0.f, 0.f, 0.f, 0.f, 0.f, 0.f, 0.f, 0.f, 0.f, 0.f};
#pragma unroll
                for (int blk = 0; blk < 8; ++blk)
#pragma unroll
                    for (int s = 0; s < 2; ++s) { const bf16x8 vf = ld_tr(vlane + (blk * 32 + s * 16) * MEM_VP + dblk * 32, 8 * MEM_VP); O = __builtin_amdgcn_mfma_f32_32x32x16_bf16(vf, pf[blk][s], O, 0, 0, 0); }
#pragma unroll
                for (int rg = 0; rg < 4; ++rg) { u32x2 w; w.x = cvt_pk_asm(O[4 * rg] * inv, O[4 * rg + 1] * inv); w.y = cvt_pk_asm(O[4 * rg + 2] * inv, O[4 * rg + 3] * inv);
                    *(u32x2*)(op + dc * 64 + dblk * 32 + 8 * rg + 4 * h) = w; }
            }
        }
    }
#undef MEM_LOADK
#undef MEM_LOADV
#undef MEM_STG
}
__device__ __forceinline__ void mem_unit(Frame& F, const Args& A, int l, int unit) { if (unit >= 256) mem_unit_t<true>(F, A, l, unit); else mem_unit_t<false>(F, A, l, unit); }

constexpr int GM_VP = 160;
constexpr int GM_TILE_BYTES = 128 * GM_VP * 2;
__device__ __forceinline__ void gmlp_unit(Frame& F, const Args& A, int l, int unit) {
    LAS float* st = (LAS float*)(F.lds + 2 * GM_TILE_BYTES);
    const bf16* Z = (const bf16*)(A.ws + WS_Z); bf16* OC = (bf16*)(A.ws + WS_OC);
    const bool samp = unit >= 384;
    int ch, gq; if (!samp) { ch = unit / 3; gq = unit - ch * 3; } else { const int u2 = unit - 384; ch = u2 / 3; gq = u2 - ch * 3; }
    const int L = samp ? 64 : 128;
    const size_t row0 = samp ? (size_t)(MP + ch * 64) : (size_t)ch * 128;
    u32x4 gw[4]; f32x4 lg0, lg1, lb0, lb1;
#define GM_LOAD(g_) do { _Pragma("unroll") for (int i_ = 0; i_ < 4; ++i_) { const int id_ = F.tid + 512 * i_, j_ = id_ >> 4, cc_ = id_ & 15; \
        gw[i_] = (j_ < L) ? *(const u32x4*)(Z + ZO_GV + (row0 + j_) * ZW_GV + (g_) * 128 + cc_ * 8) : (u32x4){0u, 0u, 0u, 0u}; } \
        { const float* gp_ = A.ln_v_g + (size_t)l * GW + (g_) * 128 + (F.tid & 15) * 8; const float* bp_ = A.ln_v_b + (size_t)l * GW + (g_) * 128 + (F.tid & 15) * 8; \
          lg0 = *(const f32x4*)gp_; lg1 = *(const f32x4*)(gp_ + 4); lb0 = *(const f32x4*)bp_; lb1 = *(const f32x4*)(bp_ + 4); } } while (0)
    const int grot = ch & 3;
    GM_LOAD(4 * gq + grot);
    if (F.tid < L) {
        const float* sp = (const float*)(A.ws + WS_STATS) + (row0 + F.tid) * 8; float s = 0.f, q = 0.f;
#pragma unroll
        for (int t6 = 0; t6 < 6; ++t6) { const f32x4 a = *(const f32x4*)(sp + (size_t)t6 * MT * 8), b = *(const f32x4*)(sp + (size_t)t6 * MT * 8 + 4); s += (a.x + a.z) + (b.x + b.z); q += (a.y + a.w) + (b.y + b.w); }
        const float mean = s * (1.f / GW); const float var = fmaxf(q * (1.f / GW) - mean * mean, 0.f);
        st[2 * F.tid] = mean; st[2 * F.tid + 1] = 1.0f / sqrtf(var + EPS);
    }
    __syncthreads();
    const int r = F.lane & 31, h = F.lane >> 5;
    const int iblk = samp ? ((F.wave >> 1) & 1) : (F.wave >> 1), cb0 = samp ? 2 * (F.wave & 1) + (F.wave >> 2) : 2 * (F.wave & 1), ncb = samp ? 1 : 2, nks = 2 * (iblk + 1);
#pragma unroll 1
    for (int gi = 0; gi < 4; ++gi) {
        const int g = 4 * gq + ((gi + grot) & 3);
        LAS bf16* Vl = (LAS bf16*)(F.lds + (gi & 1) * GM_TILE_BYTES);
        const bf16* wsb = (const bf16*)(A.ws + WS_WS) + ((size_t)l * 12 + g) * 128 * 128;
        bf16x8 bfr[8]; u32x2 uw[2][4];
        const float bias = A.b_s[(size_t)l * GW + g * 128 + iblk * 32 + r];
        { const bf16* bp = wsb + (size_t)(iblk * 32 + r) * 128 + h * 8;
#pragma unroll
          for (int ks = 0; ks < 8; ++ks) bfr[ks] = (ks < nks) ? *(const bf16x8*)(bp + ks * 16) : (bf16x8){0, 0, 0, 0, 0, 0, 0, 0}; }
#pragma unroll
        for (int cb = 0; cb < 2; ++cb) { const bf16* up = Z + ZO_U + (row0 + iblk * 32 + r) * ZW_U + g * 128 + (cb0 + cb) * 32 + 4 * h;
#pragma unroll
            for (int rg = 0; rg < 4; ++rg) uw[cb][rg] = (cb < ncb) ? *(const u32x2*)(up + 8 * rg) : (u32x2){0u, 0u}; }
        { const int cc = F.tid & 15;
          const f32x4 g0 = lg0, g1 = lg1, b0 = lb0, b1 = lb1;
#pragma unroll
          for (int i = 0; i < 4; ++i) {
            const int id = F.tid + 512 * i, j = id >> 4;
            if (j < L) {
            const u32x4 w = gw[i];
            const float mean = st[2 * j], rstd = st[2 * j + 1];
            float v[8];
            v[0] = (bf_lo(w.x) - mean) * rstd * g0.x + b0.x; v[1] = (bf_hi(w.x) - mean) * rstd * g0.y + b0.y; v[2] = (bf_lo(w.y) - mean) * rstd * g0.z + b0.z; v[3] = (bf_hi(w.y) - mean) * rstd * g0.w + b0.w;
            v[4] = (bf_lo(w.z) - mean) * rstd * g1.x + b1.x; v[5] = (bf_hi(w.z) - mean) * rstd * g1.y + b1.y; v[6] = (bf_lo(w.w) - mean) * rstd * g1.z + b1.z; v[7] = (bf_hi(w.w) - mean) * rstd * g1.w + b1.w;
            if (samp) { float* o = A.out + O_GV + (((size_t)l * DB + ch) * 64 + j) * GW + g * 128 + cc * 8; *(f32x4*)o = (f32x4){v[0], v[1], v[2], v[3]}; *(f32x4*)(o + 4) = (f32x4){v[4], v[5], v[6], v[7]}; }
            u32x4 pw; pw.x = cvt_pk_asm(v[0], v[1]); pw.y = cvt_pk_asm(v[2], v[3]); pw.z = cvt_pk_asm(v[4], v[5]); pw.w = cvt_pk_asm(v[6], v[7]);
            *(LAS u32x4*)(Vl + j * GM_VP + cc * 8) = pw;
            }
          } }
        __syncthreads();
        if (gi < 3) GM_LOAD(4 * gq + ((gi + 1 + grot) & 3));
#pragma unroll
        for (int cb = 0; cb < 2; ++cb) {
            if (cb < ncb) {
            const int cblk = cb0 + cb;
            const LAS bf16* alane = Vl + (8 * h + ((F.lane & 15) >> 2)) * GM_VP + cblk * 32 + 16 * ((F.lane >> 4) & 1) + 4 * (F.lane & 3);
            f32x16 acc = (f32x16){0.f, 0.f, 0.f, 0.f, 0.f, 0.f, 0.f, 0.f, 0.f, 0.f, 0.f, 0.f, 0.f, 0.f, 0.f, 0.f};
#pragma unroll
            for (int ks = 0; ks < 8; ++ks) { if (ks < nks) { const bf16x8 af = ld_tr(alane + (ks * 16) * GM_VP, 4 * GM_VP); acc = __builtin_amdgcn_mfma_f32_32x32x16_bf16(af, bfr[ks], acc, 0, 0, 0); } }
            const int i = iblk * 32 + r;
            bf16* op = OC + (row0 + i) * OCW + g * 128 + cblk * 32 + 4 * h;
#pragma unroll
            for (int rg = 0; rg < 4; ++rg) { u32x2 w;
                w.x = cvt_pk_asm((acc[4 * rg] + bias) * bf_lo(uw[cb][rg].x), (acc[4 * rg + 1] + bias) * bf_hi(uw[cb][rg].x)); w.y = cvt_pk_asm((acc[4 * rg + 2] + bias) * bf_lo(uw[cb][rg].y), (acc[4 * rg + 3] + bias) * bf_hi(uw[cb][rg].y));
                *(u32x2*)(op + 8 * rg) = w; }
            }
        }
    }
#undef GM_LOAD
}

constexpr int NU_MEM = 256 + 128, NU_SWA = 1024 + 128, NU_GM = 384 + 96, NU_MIX = NU_MEM + NU_SWA + NU_GM;
__device__ __forceinline__ void mixer_phase(Frame& F, const Args& A, int l, int rep) {
    gu32* ctr = F.ctl + CW_QUEUE + 64 * (l + 4 * rep);
    if (F.tid == 0) F.MISC[16] = __hip_atomic_fetch_add(ctr, 1u, RLX_AGENT);
    __syncthreads();
    int u = __builtin_amdgcn_readfirstlane((int)F.MISC[16]);
    while (u < NU_MIX) {
        unsigned nxt = 0u;
        if (F.tid == 0) nxt = __hip_atomic_fetch_add(ctr, 1u, RLX_AGENT);
        { int t_ = threadIdx.x; asm volatile("" : "+v"(t_)); F.tid = t_; F.lane = t_ & 63; }
        if (u < NU_MEM) mem_unit(F, A, l, u);
        else if (u < NU_MEM + NU_SWA) swa_unit(F, A, l, u - NU_MEM);
        else gmlp_unit(F, A, l, u - NU_MEM - NU_SWA);
        __syncthreads();
        if (F.tid == 0) F.MISC[16] = nxt;
        __syncthreads();
        u = __builtin_amdgcn_readfirstlane((int)F.MISC[16]);
    }
}

__global__ void __launch_bounds__(512, 2) trunk_fwd(Args A_unused_directly) {
    extern __shared__ __attribute__((aligned(16))) unsigned char lds[];
    Frame F;
    F.lds = (LAS unsigned char*)lds; F.MISC = (volatile LAS unsigned*)(F.lds + MISC_OFF);
    F.tid = threadIdx.x; F.lane = F.tid & 63; F.wave = __builtin_amdgcn_readfirstlane(F.tid >> 6);
    F.G = gridDim.x; { const int bx = blockIdx.x; F.vcu = (F.G % 8 == 0) ? (bx % 8) * (F.G / 8) + bx / 8 : bx; }
    { Args A; load_args(A); F.ctl = (gu32*)(A.ws + WS_CTL); }
    for (int u = F.tid; u < (LDS_BYTES - LDSCTL_OFF) / 4; u += 512) ((LAS unsigned*)(F.lds + LDSCTL_OFF))[u] = 0u;
    __syncthreads();
    XcdBarrier bar = xcd_barrier_post((unsigned*)(F.ctl + CW_BAR), F.MISC + 8);
    const int bx = (int)blockIdx.x;

    for (int cl = 0; cl < DEPTH; ++cl) { Args A; load_args(A); convert_layer(F, A, cl, F.vcu, F.G); }
    { Args A; load_args(A); p0_tables(F, A); }
    { Args A; load_args(A); p0_rows(F, A); }
    xcd_barrier(bar);

#pragma unroll 1
    for (int l = 0; l < DEPTH; ++l) {
        {
            Args A; load_args(A); const unsigned char* wl = A.ws + WS_W + (size_t)l * W_LAYER; bf16* const H = (bf16*)(A.ws + WS_H); bf16* const Z = (bf16*)(A.ws + WS_Z); bf16* const OC = (bf16*)(A.ws + WS_OC); bf16* const T1 = (bf16*)(A.ws + WS_T1); bf16* const T2 = (bf16*)(A.ws + WS_T2); (void)wl; (void)H; (void)Z; (void)OC; (void)T1; (void)T2;
            pg8::Gemm g{H, (const bf16*)(wl + W_IN), MT, C_G, DM}; pg8::StaticOrder S; S.init(MT, C_G, DM, F.G, bx, WGM_WIDE);
            pg8::EpiIn E{Z, (float*)(A.ws + WS_STATS), (const float*)(A.ws + WS_ROPE), A.out, l};
            pg8::gemm_phase(F.lds, g, S, E);
        }
        {
            Args A; load_args(A); const unsigned char* wl = A.ws + WS_W + (size_t)l * W_LAYER;
            pg8::Gemm g{(const bf16*)(A.ws + WS_H8), (const bf16*)(wl + W_G8), MT, C_G, DM / 2}; pg8::StaticOrder S; S.init(MT, C_G, DM / 2, F.G, (bx + F.G / 4) % F.G, WGM_WIDE);
            pg8::EpiGate E{(bf16*)(A.ws + WS_Z)};
            pg8::gemm_phase(F.lds, g, S, E);
        }
        {
            Args A; load_args(A); const unsigned char* wl = A.ws + WS_W + (size_t)l * W_LAYER; bf16* const H = (bf16*)(A.ws + WS_H); bf16* const Z = (bf16*)(A.ws + WS_Z); bf16* const OC = (bf16*)(A.ws + WS_OC); bf16* const T1 = (bf16*)(A.ws + WS_T1); bf16* const T2 = (bf16*)(A.ws + WS_T2); (void)wl; (void)H; (void)Z; (void)OC; (void)T1; (void)T2;
            pg8::Gemm g{(const bf16*)(A.ws + WS_MN) + (size_t)l * 1024 * DM, (const bf16*)(wl + W_MEM), 1024, 2048, DM}; pg8::StaticOrder S; S.init(1024, 2048, DM, F.G, (bx + F.G / 4) % F.G);
            pg8::EpiMemKV E{(bf16*)(A.ws + WS_MKV) + (size_t)l * 1024 * 2048, A.out + O_MKP + (size_t)l * 1024 * 1024, A.out + O_MVP + (size_t)l * 1024 * 1024};
            pg8::gemm_phase(F.lds, g, S, E);
        }
        xcd_barrier(bar);
        for (int rep = 0; rep < PROBE_REP_MIX; ++rep) { Args A; load_args(A); mixer_phase(F, A, l, rep); if (rep + 1 < PROBE_REP_MIX) xcd_barrier(bar); }
        xcd_barrier(bar);
        {
            Args A; load_args(A); const unsigned char* wl = A.ws + WS_W + (size_t)l * W_LAYER; bf16* const H = (bf16*)(A.ws + WS_H); bf16* const Z = (bf16*)(A.ws + WS_Z); bf16* const OC = (bf16*)(A.ws + WS_OC); bf16* const T1 = (bf16*)(A.ws + WS_T1); bf16* const T2 = (bf16*)(A.ws + WS_T2); (void)wl; (void)H; (void)Z; (void)OC; (void)T1; (void)T2;
            pg8::Gemm g{OC, (const bf16*)(wl + W_MG), MT, DM, OCW}; pg8::SplitOrder S; S.init(OCW, F.G, bx);
            pg8::EpiMerge E{Z, T1, (bf16*)(A.ws + WS_PARTM)};
            pg8::gemm_phase(F.lds, g, S, E);
        }
        xcd_barrier(bar);
        { Args A; load_args(A);
          int lane = F.lane; asm volatile("" : "+v"(lane));
          const bf16* PM = (const bf16*)(A.ws + WS_PARTM); bf16* T1s = (bf16*)(A.ws + WS_T1) + (size_t)MP * DM;
          for (int m = F.vcu * 8 + F.wave; m < MS; m += F.G * 8) {
              const u32x2* dr = (const u32x2*)(PM + (size_t)m * DM) + lane; u32x2* o = (u32x2*)(T1s + (size_t)m * DM) + lane;
#pragma unroll
              for (int j = 0; j < 8; ++j) { const u32x2 w0 = dr[64 * j], w1 = dr[64 * j + (size_t)MS * DM / 4], w2 = dr[64 * j + 2 * ((size_t)MS * DM / 4)], w3 = dr[64 * j + 3 * ((size_t)MS * DM / 4)];
                  u32x2 w; w.x = cvt_pk_asm((bf_lo(w0.x) + bf_lo(w1.x)) + (bf_lo(w2.x) + bf_lo(w3.x)), (bf_hi(w0.x) + bf_hi(w1.x)) + (bf_hi(w2.x) + bf_hi(w3.x)));
                  w.y = cvt_pk_asm((bf_lo(w0.y) + bf_lo(w1.y)) + (bf_lo(w2.y) + bf_lo(w3.y)), (bf_hi(w0.y) + bf_hi(w1.y)) + (bf_hi(w2.y) + bf_hi(w3.y))); o[64 * j] = w; } } }
        xcd_barrier(bar);
        {
            Args A; load_args(A); const unsigned char* wl = A.ws + WS_W + (size_t)l * W_LAYER; bf16* const H = (bf16*)(A.ws + WS_H); bf16* const Z = (bf16*)(A.ws + WS_Z); bf16* const OC = (bf16*)(A.ws + WS_OC); bf16* const T1 = (bf16*)(A.ws + WS_T1); bf16* const T2 = (bf16*)(A.ws + WS_T2); (void)wl; (void)H; (void)Z; (void)OC; (void)T1; (void)T2;
            pg8::Gemm g{T1, (const bf16*)(wl + W_O), MT, DM, DM}; pg8::SplitOrder S; S.init(DM, F.G, bx);
            pg8::EpiStoreSplit E{T2, (bf16*)(A.ws + WS_PART)};
            pg8::gemm_phase(F.lds, g, S, E);
        }
        xcd_barrier(bar);
        { Args A; load_args(A); thin_phase(F, A, (const bf16*)(A.ws + WS_T2), (const bf16*)(A.ws + WS_PART), A.norm_mix_post + (size_t)l * DM, A.norm_ffn_pre + (size_t)l * DM, A.norm_mix_pre + (size_t)l * DM, l == 0, false, false); }
        xcd_barrier(bar);
        {
            Args A; load_args(A); const unsigned char* wl = A.ws + WS_W + (size_t)l * W_LAYER; bf16* const H = (bf16*)(A.ws + WS_H); bf16* const Z = (bf16*)(A.ws + WS_Z); bf16* const OC = (bf16*)(A.ws + WS_OC); bf16* const T1 = (bf16*)(A.ws + WS_T1); bf16* const T2 = (bf16*)(A.ws + WS_T2); (void)wl; (void)H; (void)Z; (void)OC; (void)T1; (void)T2;
            pg8::Gemm g{H, (const bf16*)(wl + W_UP), MT, FF, DM}; pg8::StaticOrder S; S.init(MT, FF, DM, F.G, bx, WGM_WIDE);
            pg8::EpiStore<1> E{Z  , FF};
            pg8::gemm_phase(F.lds, g, S, E);
        }
        xcd_barrier(bar);
        {
            Args A; load_args(A); const unsigned char* wl = A.ws + WS_W + (size_t)l * W_LAYER; bf16* const H = (bf16*)(A.ws + WS_H); bf16* const Z = (bf16*)(A.ws + WS_Z); bf16* const OC = (bf16*)(A.ws + WS_OC); bf16* const T1 = (bf16*)(A.ws + WS_T1); bf16* const T2 = (bf16*)(A.ws + WS_T2); (void)wl; (void)H; (void)Z; (void)OC; (void)T1; (void)T2;
            pg8::Gemm g{Z, (const bf16*)(wl + W_DN), MT, DM, FF}; pg8::SplitOrder S; S.init(FF, F.G, bx);
            pg8::EpiStoreSplit E{T1, (bf16*)(A.ws + WS_PART)};
            pg8::gemm_phase(F.lds, g, S, E);
        }
        xcd_barrier(bar);
        { Args A; load_args(A); thin_phase(F, A, (const bf16*)(A.ws + WS_T1), (const bf16*)(A.ws + WS_PART), A.norm_ffn_post + (size_t)l * DM, (l + 1 < DEPTH) ? A.norm_mix_pre + (size_t)(l + 1) * DM : nullptr, A.norm_ffn_pre + (size_t)l * DM, false, l + 1 == DEPTH, true); }
        if (l + 1 < DEPTH) xcd_barrier(bar);
    }
}

extern "C" void kernel_launch(void* const* d_in, const int* in_sizes, int n_in, void* d_out, int out_size, void* d_ws, size_t ws_size, hipStream_t stream) {
    static int grid = 0;
    if (grid == 0) {
        if (n_in != 26 || in_sizes[0] != MP * DM || (size_t)out_size != O_END || ws_size < WS_END) {
            fprintf(stderr, "kernel_launch: unexpected problem (n_in %d, in0 %d, out %d, ws %zu; need ws >= %zu); nothing launched\n", n_in, n_in > 0 ? in_sizes[0] : -1, out_size, ws_size, (size_t)WS_END); grid = -1; return; }
        int dev = 0, cus = 0, per_cu = 0;
        if (hipGetDevice(&dev) != hipSuccess || hipDeviceGetAttribute(&cus, hipDeviceAttributeMultiprocessorCount, dev) != hipSuccess) { fprintf(stderr, "kernel_launch: device query failed\n"); grid = -1; return; }
        if (hipFuncSetAttribute((const void*)trunk_fwd, hipFuncAttributeMaxDynamicSharedMemorySize, LDS_BYTES) != hipSuccess) { fprintf(stderr, "kernel_launch: hipFuncSetAttribute failed\n"); grid = -1; return; }
        if (hipOccupancyMaxActiveBlocksPerMultiprocessor(&per_cu, (const void*)trunk_fwd, 512, LDS_BYTES) != hipSuccess || per_cu < 1)
            fprintf(stderr, "kernel_launch: note: occupancy query reports %d workgroups per CU\n", per_cu);
        (void)hipGetLastError();
        grid = cus;
    }
    if (grid < 0) return;
    if (hipMemsetAsync((char*)d_ws + WS_CTL, 0, CTL_ZERO_BYTES, stream) != hipSuccess) { fprintf(stderr, "kernel_launch: memset failed\n"); return; }
    Args a{};
    const float** ap = (const float**)&a;
    for (int i = 0; i < 26; ++i) ap[i] = (const float*)d_in[i];
    a.out = (float*)d_out; a.ws = (unsigned char*)d_ws;
    hipLaunchKernelGGL(trunk_fwd, dim3(grid), dim3(512), LDS_BYTES, stream, a);
    const hipError_t le = hipPeekAtLastError();
    if (le != hipSuccess) fprintf(stderr, "kernel_launch: launch failed: %s\n", hipGetErrorName(le));
}
```

```cpp
#include <hip/hip_runtime.h>
#include <cstdio>
#include <cstdint>

#ifndef PROBE_REP_MIX
#define PROBE_REP_MIX 1
#endif
#ifndef PROBE_REP_CONV
#define PROBE_REP_CONV 1
#endif
constexpr int DM = 2048, NB = 4, SEQ = 4096, DEPTH = 4, DB = 32, DS = 64, PAST = 1024;
constexpr int MP = NB * SEQ, MS = DB * DS, MT = MP + MS;
constexpr int INW = 12288, FF = 8192, OCW = 4096;
constexpr int C_U = 0, C_GV = 1536, C_Q = 3072, C_K = 4608, C_V = 4864, C_CQ = 5120, C_G = 6144;
constexpr int GW = 1536;
constexpr size_t ZO_U = 0, ZO_GV = (size_t)(16384 + 2048) * C_GV, ZO_Q = (size_t)(16384 + 2048) * C_Q, ZO_KV = (size_t)(16384 + 2048) * C_K, ZO_CQ = (size_t)(16384 + 2048) * C_CQ, ZO_GATE_B = (size_t)(16384 + 2048) * C_G * 2;
constexpr int ZW_U = 1536, ZW_GV = 1536, ZW_Q = 1536, ZW_KV = 512, ZW_CQ = 1024, ZW_GATE_B = 6144;
constexpr float EPS = 1e-6f, LOG2E = 1.4426950408889634f;
constexpr size_t O_Y = 0;
constexpr size_t O_KP = (size_t)MT * DM;
constexpr size_t O_VP = O_KP + (size_t)DEPTH * NB * 128 * 256;
constexpr size_t O_MKP = O_VP + (size_t)DEPTH * NB * 128 * 256;
constexpr size_t O_MVP = O_MKP + (size_t)DEPTH * 1024 * 1024;
constexpr size_t O_KS = O_MVP + (size_t)DEPTH * 1024 * 1024;
constexpr size_t O_VS = O_KS + (size_t)DEPTH * MS * 256;
constexpr size_t O_GV = O_VS + (size_t)DEPTH * MS * 256;
constexpr size_t O_END = O_GV + (size_t)DEPTH * MS * GW;
static_assert(O_END == 63963136, "output size");

constexpr size_t MiB = 1u << 20;
constexpr size_t WS_CTL = 0, CTL_ZERO_BYTES = 1 * MiB;
constexpr size_t WS_ROPE = 1 * MiB;
constexpr size_t WS_WS = 2 * MiB;
constexpr size_t WS_STATS = 4 * MiB;
constexpr size_t WS_SIG = 7 * MiB + MiB / 2;
constexpr size_t WS_MN = 8 * MiB;
constexpr size_t WS_MKV = 24 * MiB;
constexpr size_t WS_W = 40 * MiB;
constexpr size_t W_G8 = 24 * MiB;
constexpr size_t W_IN = 0, W_MG = 48 * MiB, W_O = 64 * MiB, W_UP = 72 * MiB, W_DN = 104 * MiB, W_MEM = 136 * MiB, W_LAYER = 144 * MiB;
constexpr size_t WS_H = WS_W + 4 * W_LAYER;
constexpr size_t WS_Z = WS_H + 72 * MiB;
constexpr size_t WS_OC = WS_Z + 432 * MiB;
constexpr size_t WS_T1 = WS_OC + 144 * MiB;
constexpr size_t WS_T2 = WS_T1 + 72 * MiB;
constexpr size_t WS_PART = WS_T2 + 72 * MiB;
constexpr size_t WS_XB = WS_PART + 32 * MiB;
constexpr size_t WS_PARTM = WS_XB + 72 * MiB;
constexpr size_t WS_H8 = WS_PARTM + 32 * MiB;
constexpr size_t WS_END = WS_H8 + 36 * MiB;
constexpr int CW_TMO = 0, CW_CODE = 1, CW_QUEUE = 256  , CW_BAR = 4096;

constexpr int RING_BYTES = 131072, LDSCTL_OFF = RING_BYTES, MISC_OFF = LDSCTL_OFF + 320, LDS_BYTES = 147456;

#define GAS __attribute__((address_space(1)))
#define LAS __attribute__((address_space(3)))
typedef unsigned short bf16;
typedef short bf16x8 __attribute__((ext_vector_type(8)));
typedef short s16x4 __attribute__((ext_vector_type(4)));
typedef float f32x4 __attribute__((ext_vector_type(4)));
typedef float f32x16 __attribute__((ext_vector_type(16)));
typedef unsigned u32x4 __attribute__((ext_vector_type(4)));
typedef unsigned u32x2 __attribute__((ext_vector_type(2)));
typedef GAS unsigned gu32;

typedef float f32x2_t __attribute__((ext_vector_type(2))); typedef __bf16 bf16x2_t __attribute__((ext_vector_type(2)));
__device__ __forceinline__ unsigned cvt_pk_bf16(float lo, float hi) { const f32x2_t v = {lo, hi}; const bf16x2_t b = __builtin_convertvector(v, bf16x2_t); return __builtin_bit_cast(unsigned, b); }
__device__ __forceinline__ unsigned cvt_pk_asm(float lo, float hi) { unsigned r; asm volatile("v_cvt_pk_bf16_f32 %0, %1, %2" : "=v"(r) : "v"(lo), "v"(hi)); return r; }
__device__ __forceinline__ float bf_lo(unsigned w) { return __uint_as_float(w << 16); }
__device__ __forceinline__ float bf_hi(unsigned w) { return __uint_as_float(w & 0xffff0000u); }
__device__ __forceinline__ float fexp2(float x) { return __builtin_amdgcn_exp2f(x); }
__device__ __forceinline__ float frcp(float x) { return __builtin_amdgcn_rcpf(x); }
__device__ __forceinline__ float gelu_tanh(float x) { const float t = x + 0.044715f * x * x * x; return x * frcp(1.0f + fexp2(-2.302208198144325f * t)); }
__device__ __forceinline__ float sigmoidf_(float x) { return frcp(1.0f + fexp2(-LOG2E * x)); }
__device__ __forceinline__ int lane_id() { return (int)__builtin_amdgcn_mbcnt_hi(~0u, __builtin_amdgcn_mbcnt_lo(~0u, 0u)); }
#define LDS_WAIT() asm volatile("s_waitcnt lgkmcnt(0)" ::: "memory")
#define VM_WAIT() asm volatile("s_waitcnt vmcnt(0)" ::: "memory")
#define RLX_AGENT __ATOMIC_RELAXED, __HIP_MEMORY_SCOPE_AGENT

#ifndef WGM_WIDE
#define WGM_WIDE 8
#endif
namespace pg8 {
constexpr int BM = 256, BK = 64, HALF = 128, HTB = HALF * BK * 2, STAGE_BYTES = 8 * HTB, NXCD = 8, WGM = 4;
__host__ __device__ __forceinline__ int lds_byte(int r, int c) { const int st = (r >> 4) * 2 + (c >> 5), rr = r & 15, cc = c & 31, ob = rr * 64 + cc * 2; return st * 1024 + (ob ^ (((ob >> 9) & 1) << 5)); }
__host__ __device__ __forceinline__ void stage_rc(int b, int& R, int& C) { const int st = b / 1024, sb = b % 1024, swz = sb ^ (((sb >> 9) & 1) << 5); R = (st >> 1) * 16 + swz / 64; C = (st & 1) * 32 + (swz % 64) / 2; }
__host__ __device__ __forceinline__ int perm32(int rho) { const int n = rho >> 4, i = rho & 15; return 8 * (i >> 2) + 4 * n + (i & 3); }
struct Unit { int pm, pn, kq, nt; };
struct Gemm { const bf16* A; const bf16* Bt; int M, N, K; };
struct StaticOrder {
    int nM, nN, nwg, G, c;
    int ntk, wgm;
    __device__ void init(int M, int N, int K, int G_, int c_, int wgm_ = WGM) { nM = M / BM; nN = N / BM; nwg = nM * nN; G = G_; c = c_; ntk = K / BK; wgm = wgm_; }
    __device__ bool next(int i, Unit& u) const {
        const long L = (long)i * G + c; if (L >= nwg) return false;
        u.kq = 0; u.nt = ntk;
        int wgid = (int)L; { const int q = nwg / NXCD, r = nwg % NXCD, xcd = wgid % NXCD, off = wgid / NXCD; wgid = (xcd < r ? xcd * (q + 1) : r * (q + 1) + (xcd - r) * q) + off; }
        const int nig = wgm * nN, gid = wgid / nig, fm = gid * wgm, gsz = (nM - fm) < wgm ? (nM - fm) : wgm;
        u.pm = fm + ((wgid % nig) % gsz); u.pn = (wgid % nig) / gsz; return true;
    }
};
struct SplitOrder {
    StaticOrder P; int nP;
    __device__ void init(int K, int G_, int c_) { P.init(MP, DM, K, G_, c_); nP = P.nwg; }
    __device__ bool next(int i, Unit& u) const {
        Unit a; a.pm = 0; a.pn = 0; a.kq = 0; a.nt = P.ntk; const bool okp = P.next(i, a);
        const int s = i * P.G + P.c - nP; const bool oks = !okp && s >= 0 && s < 256;
        u.pm = okp ? a.pm : 64 + (s >> 5); u.pn = okp ? a.pn : ((s >> 2) & 7); u.kq = okp ? 0 : (s & 3); u.nt = okp ? P.ntk : (P.ntk >> 2);
        return okp || oks;
    }
};
typedef int v8i_t __attribute__((ext_vector_type(8))); typedef int v4i_t __attribute__((ext_vector_type(4)));
__device__ __forceinline__ v8i_t cat8(bf16x8 a, bf16x8 b) { const v4i_t x = __builtin_bit_cast(v4i_t, a), y = __builtin_bit_cast(v4i_t, b); return __builtin_shufflevector(x, y, 0, 1, 2, 3, 4, 5, 6, 7); }
template <class Epi, class Sched>
__device__ __forceinline__ void gemm_phase(LAS unsigned char* lds, const Gemm g, const Sched& S, const Epi& E) {
    static_assert(Epi::PERM, "all epilogues here use the 8-consecutive-column layout");
    int tid_ = threadIdx.x; asm volatile("" : "+v"(tid_));
    const int tid = tid_, wid = __builtin_amdgcn_readfirstlane(tid >> 6), lane = tid & 63, wr = wid >> 2, wc = wid & 3, fr = lane & 15, fq = lane >> 4;
    const int K = g.K;
    int sc127 = 127; asm volatile("" : "+v"(sc127));
    (void)sc127;
    unsigned voffA[2], voffB[2];
#pragma unroll
    for (int i = 0; i < 2; ++i) { int R, C; stage_rc(tid * 16 + i * 8192, R, C); const int Rb = (R & ~31) + perm32(R & 31);
        voffA[i] = (unsigned)(R * K + C) * 2u; voffB[i] = (unsigned)(Rb * K + C) * 2u; }
    const size_t kstep = (size_t)(BK * 2);
    const size_t hstep = (size_t)HALF * K * 2;
    const size_t tstep = 2 * hstep;
    const unsigned ldsw = (unsigned)wid * 1024u;
    const unsigned ldsb = (unsigned)(__UINTPTR_TYPE__)lds + ldsw;
    const int aoff = lds_byte(wr * 64 + fr, fq * 8), boff = lds_byte(wc * 32 + fr, fq * 8);
#define PG8_SA(b, h) (((b) * 2 + (h)) * HTB)
#define PG8_SB(b, h) ((4 + (b) * 2 + (h)) * HTB)
#define PG8_STAGE(bufoff, gbase, voff) do { _Pragma("unroll") for (int _i = 0; _i < 2; ++_i) \
        asm volatile("s_mov_b32 m0, %2\n\ts_nop 0\n\tglobal_load_lds_dwordx4 %0, %1" :: "v"((voff)[_i]), "s"((const char*)(gbase)), "s"(ldsb + (unsigned)((bufoff) + _i * 8192)) : "memory"); } while (0)
#define PG8_LDA(dst, b, h) do { _Pragma("unroll") for (int m = 0; m < 4; ++m) _Pragma("unroll") for (int k = 0; k < 2; ++k) dst[m][k] = *(const LAS bf16x8*)(lds + PG8_SA(b, h) + aoff + m * 2048 + k * 1024); } while (0)
#define PG8_LDB(dst, b, h) do { _Pragma("unroll") for (int n = 0; n < 2; ++n) _Pragma("unroll") for (int k = 0; k < 2; ++k) dst[n][k] = *(const LAS bf16x8*)(lds + PG8_SB(b, h) + boff + n * 2048 + k * 1024); } while (0)
#define PG8_MMA(ai, bj, At, Bt) do { __builtin_amdgcn_s_setprio(1); _Pragma("unroll") for (int m = 0; m < 4; ++m) _Pragma("unroll") for (int n = 0; n < 2; ++n) { \
        if constexpr (Epi::FP8) { const v8i_t a8_ = cat8(Bt[n][0], Bt[n][1]), b8_ = cat8(At[m][0], At[m][1]); \
            asm volatile("v_mfma_scale_f32_16x16x128_f8f6f4 %0, %1, %2, %0, %3, %3 op_sel_hi:[0,0,0]" : "+v"(acc[ai][bj][m][n]) : "v"(a8_), "v"(b8_), "v"(sc127)); } \
        else { _Pragma("unroll") for (int k = 0; k < 2; ++k) acc[ai][bj][m][n] = __builtin_amdgcn_mfma_f32_16x16x32_bf16(Bt[n][k], At[m][k], acc[ai][bj][m][n], 0, 0, 0); } } __builtin_amdgcn_s_setprio(0); } while (0)
#define PG8_WAIT_V(n) asm volatile("s_waitcnt vmcnt(" #n ")" ::: "memory")
#define PG8_WAIT_L(n) asm volatile("s_waitcnt lgkmcnt(" #n ")" ::: "memory")
#define PG8_BAR __builtin_amdgcn_s_barrier()
#define PG8_SCHED __builtin_amdgcn_sched_barrier(0)
    Unit cur, nxt; int ui = 0;
    if (!S.next(0, cur)) return;
    f32x4 acc[2][2][4][2];
#pragma unroll
    for (int a = 0; a < 2; ++a)
#pragma unroll
        for (int b = 0; b < 2; ++b)
#pragma unroll
            for (int m = 0; m < 4; ++m)
#pragma unroll
                for (int n = 0; n < 2; ++n) acc[a][b][m][n] = (f32x4){0.f, 0.f, 0.f, 0.f};
    bf16x8 At[4][2], B0[2][2], B1[2][2];
    const char* cA = (const char*)g.A + (size_t)cur.pm * tstep + (size_t)(cur.kq * cur.nt) * kstep; const char* cB = (const char*)g.Bt + (size_t)cur.pn * tstep + (size_t)(cur.kq * cur.nt) * kstep;
    PG8_STAGE(PG8_SB(0, 0), cB, voffB); PG8_STAGE(PG8_SB(0, 1), cB + hstep, voffB); PG8_STAGE(PG8_SA(0, 0), cA, voffA); PG8_STAGE(PG8_SA(0, 1), cA + hstep, voffA);
    if (wr == 1) PG8_BAR;
    PG8_WAIT_V(2); PG8_BAR;
    PG8_STAGE(PG8_SB(1, 0), cB + kstep, voffB); PG8_STAGE(PG8_SA(1, 0), cA + kstep, voffA); PG8_STAGE(PG8_SB(1, 1), cB + hstep + kstep, voffB);
    PG8_WAIT_V(6); PG8_BAR;
    for (;;) {
        const bool has_next = S.next(ui + 1, nxt);
        const char* nA = has_next ? (const char*)g.A + (size_t)nxt.pm * tstep + (size_t)(nxt.kq * nxt.nt) * kstep : cA; const char* nB = has_next ? (const char*)g.Bt + (size_t)nxt.pn * tstep + (size_t)(nxt.kq * nxt.nt) * kstep : cB;
        const int nt = cur.nt;
        int t = 0;
#pragma unroll 1
        for (int seg = 0; seg < (Epi::MIDK ? 3 : 1); ++seg) {
        int tend = nt; if constexpr (Epi::MIDK) tend = E.seg_end(cur, seg);
#pragma unroll 1
        for (; t < tend; t += 2) {
            const bool last = (t == nt - 2);
            const char* a1 = cA + (size_t)(t + 1) * kstep;
            const char* a2 = last ? nA : cA + (size_t)(t + 2) * kstep; const char* b2 = last ? nB : cB + (size_t)(t + 2) * kstep;
            const char* a3 = a2 + kstep; const char* b3 = b2 + kstep;
            PG8_LDB(B0, 0, 0); PG8_LDB(B1, 0, 1); PG8_SCHED; PG8_LDA(At, 0, 0); PG8_STAGE(PG8_SA(1, 1), a1 + hstep, voffA);
            PG8_WAIT_V(8); PG8_WAIT_L(0); PG8_BAR; PG8_MMA(0, 0, At, B0); PG8_MMA(0, 1, At, B1); PG8_BAR; PG8_SCHED;
            PG8_LDA(At, 0, 1); PG8_STAGE(PG8_SB(0, 0), b2, voffB); PG8_STAGE(PG8_SB(0, 1), b2 + hstep, voffB); PG8_STAGE(PG8_SA(0, 0), a2, voffA);
            PG8_WAIT_V(8); PG8_WAIT_L(0); PG8_BAR; PG8_MMA(1, 0, At, B0); PG8_MMA(1, 1, At, B1); PG8_BAR; PG8_SCHED;
            PG8_LDB(B0, 1, 0); PG8_LDB(B1, 1, 1); PG8_SCHED; PG8_LDA(At, 1, 0); PG8_STAGE(PG8_SA(0, 1), a2 + hstep, voffA);
            PG8_WAIT_V(8); PG8_WAIT_L(0); PG8_BAR; PG8_MMA(0, 0, At, B0); PG8_MMA(0, 1, At, B1); PG8_BAR; PG8_SCHED;
            PG8_LDA(At, 1, 1); PG8_STAGE(PG8_SB(1, 0), b3, voffB); PG8_STAGE(PG8_SB(1, 1), b3 + hstep, voffB); PG8_STAGE(PG8_SA(1, 0), a3, voffA);
            PG8_WAIT_V(8); PG8_WAIT_L(0); PG8_BAR; PG8_MMA(1, 0, At, B0); PG8_MMA(1, 1, At, B1); PG8_BAR; PG8_SCHED;
        }
        if constexpr (Epi::MIDK) { if (seg < 2 && tend < nt) E.mid(acc, cur, seg, wr, wc, fr, fq); }
        }
        if (wr == 0) PG8_BAR;
        E(acc, cur, wr, wc, fr, fq);
        if (!has_next) break;
#pragma unroll
        for (int a = 0; a < 2; ++a)
#pragma unroll
            for (int b = 0; b < 2; ++b)
#pragma unroll
                for (int m = 0; m < 4; ++m)
#pragma unroll
                    for (int n = 0; n < 2; ++n) acc[a][b][m][n] = (f32x4){0.f, 0.f, 0.f, 0.f};
        cur = nxt; cA = nA; cB = nB; ++ui;
        if (wr == 1) PG8_BAR;
    }
    PG8_WAIT_V(0);
    PG8_BAR;
#undef PG8_SA
#undef PG8_SB
#undef PG8_STAGE
#undef PG8_LDA
#undef PG8_LDB
#undef PG8_MMA
#undef PG8_WAIT_V
#undef PG8_WAIT_L
#undef PG8_BAR
#undef PG8_SCHED
}

typedef const f32x4 (&AccRef)[2][2][4][2];
__device__ __forceinline__ u32x4 pack8(const float (&v)[8]) { u32x4 w; w.x = cvt_pk_bf16(v[0], v[1]); w.y = cvt_pk_bf16(v[2], v[3]); w.z = cvt_pk_bf16(v[4], v[5]); w.w = cvt_pk_bf16(v[6], v[7]); return w; }

template <int ACT> struct EpiStore {
    static constexpr bool PERM = true, MIDK = false, FP8 = false; static constexpr int MID_T0 = -1, MID_T1 = -1, SCALE_W = 127;
    bf16* O; int ldc;
    __device__ __forceinline__ void operator()(AccRef acc, const Unit& u, int wr, int wc, int fr, int fq) const {
        const int row0 = u.pm * BM + wr * 64 + fr, col0 = u.pn * BM + wc * 32 + 8 * fq;
#pragma unroll
        for (int ai = 0; ai < 2; ++ai)
#pragma unroll
            for (int m = 0; m < 4; ++m) { bf16* rowp = O + (size_t)(row0 + ai * HALF + m * 16) * ldc + col0;
#pragma unroll
                for (int bj = 0; bj < 2; ++bj) { float v[8];
#pragma unroll
                    for (int e = 0; e < 8; ++e) { float x = acc[ai][bj][m][e >> 2][e & 3]; if (ACT == 1) { x = x > 0.f ? x : 0.f; x = x * x; } v[e] = x; }
                    *(u32x4*)(rowp + bj * HALF) = pack8(v); } }
    }
};

struct EpiStoreSplit {
    static constexpr bool PERM = true, MIDK = false, FP8 = false; static constexpr int MID_T0 = -1, MID_T1 = -1, SCALE_W = 127;
    bf16* O; bf16* P;
    __device__ __forceinline__ void operator()(AccRef acc, const Unit& u, int wr, int wc, int fr, int fq) const {
        const int row0 = u.pm * BM + wr * 64 + fr, col0 = u.pn * BM + wc * 32 + 8 * fq;
        bf16* base = (u.pm < 64) ? O + (size_t)row0 * DM + col0 : P + ((size_t)u.kq * MS + (row0 - MP)) * DM + col0;
#pragma unroll
        for (int ai = 0; ai < 2; ++ai)
#pragma unroll
            for (int m = 0; m < 4; ++m) { bf16* rowp = base + (size_t)(ai * HALF + m * 16) * DM;
#pragma unroll
                for (int bj = 0; bj < 2; ++bj) { float v[8];
#pragma unroll
                    for (int e = 0; e < 8; ++e) v[e] = acc[ai][bj][m][e >> 2][e & 3];
                    *(u32x4*)(rowp + bj * HALF) = pack8(v); } }
    }
};

struct EpiMemKV {
    static constexpr bool PERM = true, MIDK = false, FP8 = false; static constexpr int MID_T0 = -1, MID_T1 = -1, SCALE_W = 127;
    bf16* O; float* ok; float* ov;
    __device__ __forceinline__ void operator()(AccRef acc, const Unit& u, int wr, int wc, int fr, int fq) const {
        const int row0 = u.pm * BM + wr * 64 + fr, col0 = u.pn * BM + wc * 32 + 8 * fq;
        float* fo = (u.pn < 4) ? ok : ov; const int fcol0 = col0 & 1023;
#pragma unroll
        for (int ai = 0; ai < 2; ++ai)
#pragma unroll
            for (int m = 0; m < 4; ++m) { const int row = row0 + ai * HALF + m * 16;
#pragma unroll
                for (int bj = 0; bj < 2; ++bj) { float v[8];
#pragma unroll
                    for (int e = 0; e < 8; ++e) v[e] = acc[ai][bj][m][e >> 2][e & 3];
                    *(u32x4*)(O + (size_t)row * 2048 + col0 + bj * HALF) = pack8(v);
                    float* fp = fo + (size_t)row * 1024 + fcol0 + bj * HALF;
                    *(f32x4*)fp = acc[ai][bj][m][0]; *(f32x4*)(fp + 4) = acc[ai][bj][m][1]; } }
    }
};

struct EpiIn {
    static constexpr bool PERM = true, MIDK = false, FP8 = false; static constexpr int MID_T0 = -1, MID_T1 = -1, SCALE_W = 127;
    bf16* Z; float* stats; const float* rope; float* outl; int l;
    template <int MODE> __device__ __forceinline__ void emit(AccRef acc, const Unit& u, int wr, int wc, int fr, int fq) const {
        const bool isk = (u.pn == 18);
        const int row0 = u.pm * BM + wr * 64 + fr, ct = wc * 32 + 8 * fq;
        const bool ropelane = ((wc & 1) == 0) && (fq < 2);
        f32x4 tn[4];
        if (MODE == 2 || MODE == 3) { const int pos = row0 < MP ? (row0 & (SEQ - 1)) : (PAST + ((row0 - MP) & (DS - 1))); const f32x4* rp = (const f32x4*)(rope + (size_t)pos * 16); tn[0] = rp[0]; tn[1] = rp[1]; tn[2] = rp[2]; tn[3] = rp[3]; }
#pragma unroll
        for (int ai = 0; ai < 2; ++ai)
#pragma unroll
            for (int m = 0; m < 4; ++m) {
                const int row = row0 + ai * HALF + m * 16;
                constexpr int CR = (MODE == 0) ? C_U : (MODE == 1) ? C_GV : (MODE == 2) ? C_Q : (MODE == 3) ? C_K : C_CQ, WR = (MODE == 0 || MODE == 1 || MODE == 2) ? 1536 : (MODE == 3) ? ZW_KV : ZW_CQ;
                bf16* zp = Z + (size_t)MT * CR + (size_t)row * WR + (u.pn * BM - CR) + ct;
                float cs[8], sn[8];
                if (MODE == 2 || MODE == 3) {
#pragma unroll
                    for (int e = 0; e < 4; ++e) { cs[e] = tn[0][e]; cs[4 + e] = tn[1][e]; sn[e] = tn[2][e]; sn[4 + e] = tn[3][e]; }
                    if (ai * 4 + m < 7) { const int rown = row0 + ((ai * 4 + m + 1) >> 2) * HALF + ((ai * 4 + m + 1) & 3) * 16;
                        const int pos = rown < MP ? (rown & (SEQ - 1)) : (PAST + ((rown - MP) & (DS - 1))); const f32x4* rp = (const f32x4*)(rope + (size_t)pos * 16); tn[0] = rp[0]; tn[1] = rp[1]; tn[2] = rp[2]; tn[3] = rp[3]; }
                }
                float* fdst = nullptr;
                if (MODE == 3) {
                    if (row < MP) { const int pos = row & (SEQ - 1); if (pos >= SEQ - 128) fdst = outl + (isk ? O_KP : O_VP) + ((size_t)((l * NB + (row >> 12)) * 128 + pos - (SEQ - 128))) * 256 + ct; }
                    else fdst = outl + (isk ? O_KS : O_VS) + ((size_t)l * MS + (row - MP)) * 256 + ct;
                }
                float ssum = 0.f, ssq = 0.f;
#pragma unroll
                for (int bj = 0; bj < 2; ++bj) { float v[8];
#pragma unroll
                    for (int e = 0; e < 8; ++e) v[e] = acc[ai][bj][m][e >> 2][e & 3];
                    if (MODE == 0 || MODE == 1) {
#pragma unroll
                        for (int e = 0; e < 8; ++e) v[e] = gelu_tanh(v[e]);
                    }
                    if (MODE == 1) {
#pragma unroll
                        for (int e = 0; e < 8; ++e) { ssum += v[e]; ssq += v[e] * v[e]; }
                    }
                    if (MODE == 2 || (MODE == 3 && isk)) {
#pragma unroll
                        for (int e = 0; e < 8; ++e) { const float p = __shfl_xor(v[e], 16); const float rv = (fq == 0) ? (v[e] * cs[e] - p * sn[e]) : (v[e] * cs[e] + p * sn[e]); v[e] = ropelane ? rv : v[e]; }
                    }
                    if (MODE == 6) {
                        unsigned q[8];
#pragma unroll
                        for (int e = 0; e < 8; ++e) q[e] = (unsigned)__builtin_rintf(fminf(fmaxf(sigmoidf_(v[e]) * 255.0f, 1.0f), 255.0f));
                        u32x2 w; w.x = q[0] | (q[1] << 8) | (q[2] << 16) | (q[3] << 24); w.y = q[4] | (q[5] << 8) | (q[6] << 16) | (q[7] << 24);
                        *(u32x2*)((unsigned char*)Z + ZO_GATE_B + (size_t)row * ZW_GATE_B + (u.pn - 24) * BM + bj * HALF + ct) = w;
                    } else
                    *(u32x4*)(zp + bj * HALF) = pack8(v);
                    if (MODE == 3) { if (fdst) { *(f32x4*)(fdst + bj * HALF) = (f32x4){v[0], v[1], v[2], v[3]}; *(f32x4*)(fdst + bj * HALF + 4) = (f32x4){v[4], v[5], v[6], v[7]}; } }
                }
                if (MODE == 1) {
                    ssum += __shfl_xor(ssum, 16); ssum += __shfl_xor(ssum, 32); ssq += __shfl_xor(ssq, 16); ssq += __shfl_xor(ssq, 32);
                    if (fq == 0) { typedef float f32x2 __attribute__((ext_vector_type(2))); *(f32x2*)(stats + (((size_t)(u.pn - 6) * MT + row) * 4 + wc) * 2) = (f32x2){ssum, ssq}; }
                }
                asm volatile("" ::: "memory");
            }
    }
    __device__ __forceinline__ void operator()(AccRef acc, const Unit& u, int wr, int wc, int fr, int fq) const {
        const int pn = u.pn;
        if (pn < 6) emit<0>(acc, u, wr, wc, fr, fq);
        else if (pn < 12) emit<1>(acc, u, wr, wc, fr, fq);
        else if (pn < 18) emit<2>(acc, u, wr, wc, fr, fq);
        else if (pn < 20) emit<3>(acc, u, wr, wc, fr, fq);
        else if (pn < 24) emit<5>(acc, u, wr, wc, fr, fq);
        else emit<6>(acc, u, wr, wc, fr, fq);
    }
};

struct EpiGate {
    static constexpr bool PERM = true, MIDK = false, FP8 = true; static constexpr int MID_T0 = -1, MID_T1 = -1, SCALE_W = 127 - 6;
    bf16* Z;
    __device__ __forceinline__ void operator()(AccRef acc, const Unit& u, int wr, int wc, int fr, int fq) const {
        const int row0 = u.pm * BM + wr * 64 + fr, ct = wc * 32 + 8 * fq;
#pragma unroll
        for (int ai = 0; ai < 2; ++ai)
#pragma unroll
            for (int m = 0; m < 4; ++m) { unsigned char* gp = (unsigned char*)Z + ZO_GATE_B + (size_t)(row0 + ai * HALF + m * 16) * ZW_GATE_B + u.pn * BM + ct;
#pragma unroll
                for (int bj = 0; bj < 2; ++bj) { unsigned q[8];
#pragma unroll
                    for (int e = 0; e < 8; ++e) q[e] = (unsigned)fmaxf(__builtin_fmaf(frcp(1.0f + fexp2(acc[ai][bj][m][e >> 2][e & 3] * (-LOG2E / 64.0f))), 255.0f, 0.5f), 1.0f);
                    u32x2 w; w.x = q[0] | (q[1] << 8) | (q[2] << 16) | (q[3] << 24); w.y = q[4] | (q[5] << 8) | (q[6] << 16) | (q[7] << 24);
                    *(u32x2*)(gp + bj * HALF) = w; } }
    }
};

struct EpiMerge {
    static constexpr bool PERM = true, MIDK = true, FP8 = false; static constexpr int MID_T0 = 1536 / BK, MID_T1 = 3072 / BK, SCALE_W = 127;
    const bf16* Z; bf16* O; bf16* P;
    __device__ __forceinline__ int seg_end(const Unit& u, int seg) const {
        if (u.pm < 64) return seg == 0 ? MID_T0 : seg == 1 ? MID_T1 : u.nt;
        return (seg == 0 && u.kq == 1) ? 8 : u.nt;
    }
    static __device__ __forceinline__ float ub(unsigned w, int k) { return (float)((w >> (8 * k)) & 255u); }
    __device__ __forceinline__ void mid(f32x4 (&acc)[2][2][4][2], const Unit& u, int st, int wr, int wc, int fr, int fq) const {
        const int row0 = u.pm * BM + wr * 64 + fr, col0 = u.pn * BM + wc * 32 + 8 * fq;
        const unsigned char* gbase = (const unsigned char*)Z + ZO_GATE_B + (size_t)row0 * ZW_GATE_B + st * DM + col0;
        u32x2 ga[2][4][2], gb[2][4][2];
#pragma unroll
        for (int ai = 0; ai < 2; ++ai)
#pragma unroll
            for (int m = 0; m < 4; ++m) { const unsigned char* gp = gbase + (size_t)(ai * HALF + m * 16) * ZW_GATE_B;
#pragma unroll
                for (int bj = 0; bj < 2; ++bj) { ga[ai][m][bj] = *(const u32x2*)(gp + bj * HALF); gb[ai][m][bj] = *(const u32x2*)(gp + DM + bj * HALF); } }
#pragma unroll
        for (int ai = 0; ai < 2; ++ai)
#pragma unroll
            for (int m = 0; m < 4; ++m)
#pragma unroll
                for (int bj = 0; bj < 2; ++bj)
#pragma unroll
                    for (int e = 0; e < 8; ++e) { const unsigned wa = e < 4 ? ga[ai][m][bj].x : ga[ai][m][bj].y, wb = e < 4 ? gb[ai][m][bj].x : gb[ai][m][bj].y;
                        acc[ai][bj][m][e >> 2][e & 3] *= ub(wa, e & 3) * frcp(fmaxf(ub(wb, e & 3), 1.0f)); }
    }
    __device__ __forceinline__ void operator()(AccRef acc, const Unit& u, int wr, int wc, int fr, int fq) const {
        const int row0 = u.pm * BM + wr * 64 + fr, col0 = u.pn * BM + wc * 32 + 8 * fq;
        const int fg = (u.pm < 64) ? 2 : (u.kq == 0 ? 0 : u.kq == 3 ? 2 : 1);
        bf16* dst = (u.pm < 64) ? O + (size_t)row0 * DM + col0 : P + ((size_t)u.kq * MS + (row0 - MP)) * DM + col0;
#pragma unroll
        for (int ai = 0; ai < 2; ++ai)
#pragma unroll
            for (int m = 0; m < 4; ++m) { const int row = row0 + ai * HALF + m * 16; const unsigned char* gp = (const unsigned char*)Z + ZO_GATE_B + (size_t)row * ZW_GATE_B + fg * DM + col0;
#pragma unroll
                for (int bj = 0; bj < 2; ++bj) { const u32x2 gc = *(const u32x2*)(gp + bj * HALF); float v[8];
#pragma unroll
                    for (int e = 0; e < 8; ++e) v[e] = acc[ai][bj][m][e >> 2][e & 3] * (ub(e < 4 ? gc.x : gc.y, e & 3) * (1.0f / 255.0f));
                    *(u32x4*)(dst + (size_t)(ai * HALF + m * 16) * DM + bj * HALF) = pack8(v); } }
    }
};
}

#define XB_TMO      128
#define XB_XCNT(j)  (256  + 64 * (j))
#define XB_XSUB(j)  (1280 + 64 * (j))
#define XB_XGEN(j)  (2304 + 64 * (j))
#define XB_TOP      3328
#define XB_TOPGEN   3392
#define XCD_BAR_WORDS 3456
#define XB_SPIN_CAP (1u << 18)
__device__ __forceinline__ unsigned xb_ld(unsigned* p)              { return __hip_atomic_load(p, __ATOMIC_RELAXED, __HIP_MEMORY_SCOPE_AGENT); }
__device__ __forceinline__ unsigned xb_add(unsigned* p, unsigned v) { return __hip_atomic_fetch_add(p, v, __ATOMIC_RELAXED, __HIP_MEMORY_SCOPE_AGENT); }
__device__ __forceinline__ unsigned xb_xcc_id() { return (unsigned)__builtin_amdgcn_s_getreg((3 << 11) | 20) & 0xFu; }
#define XB_SPIN(cond, bar) do { unsigned _sp = 0; while (cond) { __builtin_amdgcn_s_sleep(1); \
    if ((++_sp & 255u) == 0u) { if (xb_ld(&(bar)[XB_TMO])) break; if (_sp > XB_SPIN_CAP) { atomicAdd(&(bar)[XB_TMO], 1u); break; } } } } while (0)
struct XcdBarrier { unsigned* bar; unsigned x; volatile LAS unsigned* st; };
__device__ __forceinline__ XcdBarrier xcd_barrier_post(unsigned* bar, volatile LAS unsigned* st) {
    XcdBarrier b; b.bar = bar; b.x = xb_xcc_id(); b.st = st;
    if (threadIdx.x == 0) (void)xb_add(&bar[XB_XCNT(b.x)], 1u);
    return b;
}
__device__ __forceinline__ void xcd_barrier_complete(unsigned* bar, unsigned x, unsigned& nloc, unsigned& nx) {
    const unsigned G = gridDim.x * gridDim.y * gridDim.z;
    unsigned sum, cnt, mine, sp = 0u;
    for (;;) {
        sum = 0u; cnt = 0u; mine = 0u;
#pragma unroll
        for (unsigned j = 0; j < 16; ++j) { const unsigned c = xb_ld(&bar[XB_XCNT(j)]); sum += c; cnt += (c > 0u) ? 1u : 0u; mine = (j == x) ? c : mine; }
        if (sum == G) break;
        __builtin_amdgcn_s_sleep(1);
        if ((++sp & 255u) == 0u) { if (xb_ld(&bar[XB_TMO])) break; if (sp > XB_SPIN_CAP) { atomicAdd(&bar[XB_TMO], 1u); break; } }
    }
    nloc = mine > 0u ? mine : 1u; nx = cnt > 0u ? cnt : 1u;
}
__device__ __forceinline__ void xcd_barrier(const XcdBarrier& b) {
    asm volatile("s_waitcnt vmcnt(0)" ::: "memory");
    __syncthreads();
    if (threadIdx.x == 0) {
        unsigned* bar = b.bar;
        const unsigned bx_ = xb_xcc_id();
        __builtin_amdgcn_s_waitcnt(0);
        unsigned nloc = b.st[0], nx = b.st[1];
        if (nloc == 0u) { xcd_barrier_complete(bar, bx_, nloc, nx); b.st[0] = nloc; b.st[1] = nx; }
        const unsigned old = xb_add(&bar[XB_XSUB(bx_)], 1u);
        const unsigned gen = old / nloc;
        if (old + 1u == (gen + 1u) * nloc) {
            __builtin_amdgcn_fence(__ATOMIC_RELEASE, "agent");
            asm volatile("s_waitcnt vmcnt(0)" ::: "memory");
            const unsigned og = xb_add(&bar[XB_TOP], 1u);
            const unsigned tg = og / nx;
            if (og + 1u == (tg + 1u) * nx) xb_add(&bar[XB_TOPGEN], 1u);
            else XB_SPIN(xb_ld(&bar[XB_TOPGEN]) == tg, bar);
            __builtin_amdgcn_fence(__ATOMIC_ACQUIRE, "agent");
            xb_add(&bar[XB_XGEN(bx_)], 1u);
            asm volatile("s_waitcnt vmcnt(0)" ::: "memory");
        } else {
            XB_SPIN(xb_ld(&bar[XB_XGEN(bx_)]) == gen, bar);
            __builtin_amdgcn_fence(__ATOMIC_ACQUIRE, "agent");
            asm volatile("s_waitcnt vmcnt(0)" ::: "memory");
        }
    }
    __syncthreads();
}

struct Args {
    const float* x_prompt; const float* x_sample; const float* cache_swa_k; const float* cache_swa_v; const float* cache_mem_k; const float* cache_mem_v; const float* mem_prompt;
    const float* w_in; const float* ln_v_g; const float* ln_v_b; const float* w_s; const float* b_s; const float* sinks; const float* mem_norm; const float* w_mem_k; const float* w_mem_v;
    const float* w_pa; const float* w_pb; const float* w_pc; const float* w_o; const float* norm_mix_pre; const float* norm_mix_post; const float* norm_ffn_pre; const float* norm_ffn_post;
    const float* w_up; const float* w_down;
    float* out; unsigned char* ws;
};
#define CAS __attribute__((address_space(4)))
#define ARG_FIELDS(X) X(x_prompt) X(x_sample) X(cache_swa_k) X(cache_swa_v) X(cache_mem_k) X(cache_mem_v) X(mem_prompt) X(w_in) X(ln_v_g) X(ln_v_b) X(w_s) X(b_s) X(sinks) X(mem_norm) X(w_mem_k) X(w_mem_v) \
    X(w_pa) X(w_pb) X(w_pc) X(w_o) X(norm_mix_pre) X(norm_mix_post) X(norm_ffn_pre) X(norm_ffn_post) X(w_up) X(w_down) X(out) X(ws)
__device__ __forceinline__ void load_args(Args& L) {
    const CAS Args* p = (const CAS Args*)__builtin_amdgcn_kernarg_segment_ptr();
    asm volatile("" : "+s"(p));
#define CP_(f) L.f = p->f;
    ARG_FIELDS(CP_)
#undef CP_
}
struct Frame {
    LAS unsigned char* lds; volatile LAS unsigned* MISC; gu32* ctl;
    int tid, lane, wave, vcu, G;
};
__device__ __forceinline__ float wave_sum(float v) {
#pragma unroll
    for (int o = 1; o < 64; o <<= 1) v += __shfl_xor(v, o);
    return v;
}

__device__ __forceinline__ void transpose_item(const float* W, int ldw, bf16* WT, int ldk, LAS float* scr, int k0, int n0, int lane) {
#pragma unroll 8
    for (int i = 0; i < 32; ++i) { const int kk = 2 * i + (lane >> 5); scr[kk * 33 + (lane & 31)] = W[(size_t)(k0 + kk) * ldw + n0 + (lane & 31)]; }
    LDS_WAIT(); asm volatile("" ::: "memory");
    const int c = lane & 7;
#pragma unroll
    for (int j = 0; j < 4; ++j) { const int n = (lane >> 3) + 8 * j; const LAS float* s = scr + (8 * c) * 33 + n;
        u32x4 o; o.x = cvt_pk_asm(s[0 * 33], s[1 * 33]); o.y = cvt_pk_asm(s[2 * 33], s[3 * 33]); o.z = cvt_pk_asm(s[4 * 33], s[5 * 33]); o.w = cvt_pk_asm(s[6 * 33], s[7 * 33]);
        *(u32x4*)(WT + (size_t)(n0 + n) * ldk + k0 + 8 * c) = o; }
    LDS_WAIT(); asm volatile("" ::: "memory");
}
__device__ __forceinline__ void transpose_item_fp8(const float* W, int ldw, unsigned char* WT8, int ldk, LAS float* scr, int k0, int n0, int lane, float sc) {
#pragma unroll 8
    for (int i = 0; i < 32; ++i) { const int kk = 2 * i + (lane >> 5); scr[kk * 33 + (lane & 31)] = W[(size_t)(k0 + kk) * ldw + n0 + (lane & 31)] * sc; }
    LDS_WAIT(); asm volatile("" ::: "memory");
    const int c = lane & 7;
#pragma unroll
    for (int j = 0; j < 4; ++j) { const int n = (lane >> 3) + 8 * j; const LAS float* s = scr + (8 * c) * 33 + n;
        int lo = 0, hi = 0;
        lo = __builtin_amdgcn_cvt_pk_fp8_f32(s[0 * 33], s[1 * 33], lo, false); lo = __builtin_amdgcn_cvt_pk_fp8_f32(s[2 * 33], s[3 * 33], lo, true);
        hi = __builtin_amdgcn_cvt_pk_fp8_f32(s[4 * 33], s[5 * 33], hi, false); hi = __builtin_amdgcn_cvt_pk_fp8_f32(s[6 * 33], s[7 * 33], hi, true);
        *(u32x2*)(WT8 + (size_t)(n0 + n) * ldk + k0 + 8 * c) = (u32x2){(unsigned)lo, (unsigned)hi}; }
    LDS_WAIT(); asm volatile("" ::: "memory");
}
__device__ __forceinline__ bool conv_mat(int& r, const float* W, int K, int N, bf16* WT, int ldk, LAS float* scr, int lane) {
    const int nblk = N / 32, items = (K / 64) * nblk;
    if (r < items) { const int kb = r / nblk, nb = r - kb * nblk; transpose_item(W, N, WT, ldk, scr, 64 * kb, 32 * nb, lane); return true; }
    r -= items; return false;
}
constexpr int CONV_ITEMS_PER_LAYER = 32 * 384 + 24 * 64 * 2 + 16 * 64 + 32 * 64 + 32 * 256 + 128 * 64 + 32 * 32 * 2;

__device__ __forceinline__ void convert_layer(Frame& F, const Args& A, int l, int worker, int nworkers) {
    LAS float* scr = (LAS float*)(F.lds + F.wave * 16384);
    const int gw = worker * 8 + F.wave, NGW = nworkers * 8;
    for (int it = gw; it < CONV_ITEMS_PER_LAYER; it += NGW) {
        int r = it;
        unsigned char* wl = A.ws + WS_W + (size_t)l * W_LAYER;
        { const int nblk = C_G / 32, items = (DM / 64) * nblk;
          if (r < items) { const int kb = r / nblk, nb = r - kb * nblk; transpose_item(A.w_in + (size_t)l * DM * INW, INW, (bf16*)(wl + W_IN), DM, scr, 64 * kb, 32 * nb, F.lane); continue; } r -= items;
          if (r < items) { const int kb = r / nblk, nb = r - kb * nblk; transpose_item_fp8(A.w_in + (size_t)l * DM * INW + C_G, INW, wl + W_G8, DM, scr, 64 * kb, 32 * nb, F.lane, 64.0f); continue; } r -= items; }
        if (conv_mat(r, A.w_pa + (size_t)l * GW * DM, GW, DM, (bf16*)(wl + W_MG), OCW, scr, F.lane)) continue;
        if (conv_mat(r, A.w_pb + (size_t)l * GW * DM, GW, DM, (bf16*)(wl + W_MG) + 1536, OCW, scr, F.lane)) continue;
        if (conv_mat(r, A.w_pc + (size_t)l * 1024 * DM, 1024, DM, (bf16*)(wl + W_MG) + 3072, OCW, scr, F.lane)) continue;
        if (conv_mat(r, A.w_o + (size_t)l * DM * DM, DM, DM, (bf16*)(wl + W_O), DM, scr, F.lane)) continue;
        if (conv_mat(r, A.w_up + (size_t)l * DM * FF, DM, FF, (bf16*)(wl + W_UP), DM, scr, F.lane)) continue;
        if (conv_mat(r, A.w_down + (size_t)l * FF * DM, FF, DM, (bf16*)(wl + W_DN), FF, scr, F.lane)) continue;
        if (conv_mat(r, A.w_mem_k + (size_t)l * DM * 1024, DM, 1024, (bf16*)(wl + W_MEM), DM, scr, F.lane)) continue;
        conv_mat(r, A.w_mem_v + (size_t)l * DM * 1024, DM, 1024, (bf16*)(wl + W_MEM) + (size_t)1024 * DM, DM, scr, F.lane);
    }
}
__device__ __forceinline__ void p0_tables(Frame& F, const Args& A) {
    const int gt = (F.vcu * 8 + F.wave) * 64 + F.lane, NGT = F.G * 512;
    float* rope = (float*)(A.ws + WS_ROPE);
    for (int i = gt; i < SEQ * 8; i += NGT) {
        const int pos = i >> 3, k = i & 7;
        const double inv = (k == 0) ? 1.0 : (k == 1) ? 0.19392274474868576 : (k == 2) ? 0.03760603093086393 : (k == 3) ? 0.007292664737217109 : (k == 4) ? 0.001414213562373095
                         : (k == 5) ? 0.0002742481756762073 : (k == 6) ? 5.318295896944988e-05 : 1.031338537721246e-05;
        const double ang = (double)pos * inv;
        const double n = __builtin_rint(ang * 0.15915494309189535);
        double rr = __builtin_fma(-n, 6.283185307179586, ang); rr = __builtin_fma(-n, 2.4492935982947064e-16, rr);
        const double r2 = rr * rr;
        double sc = 1.0, ss = 1.0;
        double tc = 1.0, ts = 1.0;
#pragma unroll 1
        for (int j = 1; j <= 16; ++j) { tc *= -r2 / (double)((2 * j - 1) * (2 * j)); ts *= -r2 / (double)((2 * j) * (2 * j + 1)); sc += tc; ss += ts; }
        rope[pos * 16 + k] = (float)sc; rope[pos * 16 + 8 + k] = (float)(ss * rr);
    }
    bf16* wsb = (bf16*)(A.ws + WS_WS);
    for (int i = gt; i < DEPTH * 12 * 128 * 128 / 4; i += NGT) {
        const int e = i * 4, col = e & 127, row = (e >> 7) & 127;
        const f32x4 w = *(const f32x4*)(A.w_s + e);
        u32x2 o; o.x = cvt_pk_asm(col <= row ? w.x : 0.f, col + 1 <= row ? w.y : 0.f); o.y = cvt_pk_asm(col + 2 <= row ? w.z : 0.f, col + 3 <= row ? w.w : 0.f);
        *(u32x2*)(wsb + e) = o;
    }
}
__device__ __forceinline__ void p0_rows(Frame& F, const Args& A) {
    const int gw = F.vcu * 8 + F.wave, NGW = F.G * 8;
    for (int m = gw; m < 1024; m += NGW) {
        const f32x4* xr = (const f32x4*)(A.mem_prompt + (size_t)m * DM) + F.lane;
        f32x4 v[8]; float s = 0.f;
#pragma unroll
        for (int j = 0; j < 8; ++j) { v[j] = xr[64 * j]; s += (v[j].x * v[j].x + v[j].y * v[j].y) + (v[j].z * v[j].z + v[j].w * v[j].w); }
        const float rstd = 1.0f / sqrtf(wave_sum(s) * (1.f / DM) + EPS);
#pragma unroll 1
        for (int l = 0; l < DEPTH; ++l) {
            const f32x4* gp = (const f32x4*)(A.mem_norm + (size_t)l * DM) + F.lane;
            u32x2* o = (u32x2*)((bf16*)(A.ws + WS_MN) + ((size_t)l * 1024 + m) * DM) + F.lane;
#pragma unroll
            for (int j = 0; j < 8; ++j) { const f32x4 g = gp[64 * j]; u32x2 w; w.x = cvt_pk_asm(v[j].x * rstd * g.x, v[j].y * rstd * g.y); w.y = cvt_pk_asm(v[j].z * rstd * g.z, v[j].w * rstd * g.w); o[64 * j] = w; }
        }
    }
    f32x4 g0[8];
#pragma unroll
    for (int j = 0; j < 8; ++j) g0[j] = ((const f32x4*)A.norm_mix_pre + F.lane)[64 * j];
    for (int m = gw; m < MT; m += NGW) {
        const float* src = m < MP ? A.x_prompt + (size_t)m * DM : A.x_sample + (size_t)(m - MP) * DM;
        const f32x4* xr = (const f32x4*)src + F.lane;
        f32x4 v[8]; float s = 0.f;
#pragma unroll
        for (int j = 0; j < 8; ++j) { v[j] = xr[64 * j]; s += (v[j].x * v[j].x + v[j].y * v[j].y) + (v[j].z * v[j].z + v[j].w * v[j].w); }
        const float rstd = 1.0f / sqrtf(wave_sum(s) * (1.f / DM) + EPS);
        u32x2* o = (u32x2*)((bf16*)(A.ws + WS_H) + (size_t)m * DM) + F.lane;
#pragma unroll
        for (int j = 0; j < 8; ++j) { u32x2 w; w.x = cvt_pk_asm(v[j].x * rstd * g0[j].x, v[j].y * rstd * g0[j].y); w.y = cvt_pk_asm(v[j].z * rstd * g0[j].z, v[j].w * rstd * g0[j].w); o[64 * j] = w; }
        unsigned* o8 = (unsigned*)(A.ws + WS_H8 + (size_t)m * DM) + F.lane;
#pragma unroll
        for (int j = 0; j < 8; ++j) { int w8 = 0; w8 = __builtin_amdgcn_cvt_pk_fp8_f32(v[j].x * rstd * g0[j].x, v[j].y * rstd * g0[j].y, w8, false); w8 = __builtin_amdgcn_cvt_pk_fp8_f32(v[j].z * rstd * g0[j].z, v[j].w * rstd * g0[j].w, w8, true); o8[64 * j] = (unsigned)w8; }
    }
}
__device__ __forceinline__ void thin_phase(Frame& F, const Args& A, const bf16* D, const bf16* PART, const float* gpost, const float* gnext, const float* gprev, bool first, bool last, bool h8) {
    const int gw = F.vcu * 8 + F.wave, NGW = F.G * 8;
    int lane = F.lane; asm volatile("" : "+v"(lane));
    f32x4 gp[8], gn[8], gi[8];
#pragma unroll
    for (int j = 0; j < 8; ++j) { gp[j] = ((const f32x4*)gpost + lane)[64 * j]; gn[j] = gnext ? ((const f32x4*)gnext + lane)[64 * j] : (f32x4){0.f, 0.f, 0.f, 0.f};
        const f32x4 gv = first ? (f32x4){1.f, 1.f, 1.f, 1.f} : ((const f32x4*)gprev + lane)[64 * j]; gi[j] = (f32x4){1.0f / gv.x, 1.0f / gv.y, 1.0f / gv.z, 1.0f / gv.w}; }
    bf16* const HB = (bf16*)(A.ws + WS_H); float* const SIG = (float*)(A.ws + WS_SIG);
    for (int m = gw; m < MT; m += NGW) {
        f32x4 d[8], x[8]; float s = 0.f;
        if (m < MP) {
            const u32x2* dr = (const u32x2*)(D + (size_t)m * DM) + lane;
#pragma unroll
            for (int j = 0; j < 8; ++j) { const u32x2 w = dr[64 * j]; d[j] = (f32x4){bf_lo(w.x), bf_hi(w.x), bf_lo(w.y), bf_hi(w.y)}; }
        } else {
            const u32x2* dr = (const u32x2*)(PART + (size_t)(m - MP) * DM) + lane;
#pragma unroll
            for (int j = 0; j < 8; ++j) { const u32x2 w0 = dr[64 * j], w1 = dr[64 * j + (size_t)MS * DM / 4], w2 = dr[64 * j + 2 * ((size_t)MS * DM / 4)], w3 = dr[64 * j + 3 * ((size_t)MS * DM / 4)];
                d[j] = (f32x4){(bf_lo(w0.x) + bf_lo(w1.x)) + (bf_lo(w2.x) + bf_lo(w3.x)), (bf_hi(w0.x) + bf_hi(w1.x)) + (bf_hi(w2.x) + bf_hi(w3.x)),
                               (bf_lo(w0.y) + bf_lo(w1.y)) + (bf_lo(w2.y) + bf_lo(w3.y)), (bf_hi(w0.y) + bf_hi(w1.y)) + (bf_hi(w2.y) + bf_hi(w3.y))}; }
        }
        if (first) {
            const f32x4* xs = (const f32x4*)(m < MP ? A.x_prompt + (size_t)m * DM : A.x_sample + (size_t)(m - MP) * DM) + lane;
#pragma unroll
            for (int j = 0; j < 8; ++j) x[j] = xs[64 * j];
        } else {
            const u32x2* xs = (const u32x2*)(HB + (size_t)m * DM) + lane; const float sg = SIG[m];
#pragma unroll
            for (int j = 0; j < 8; ++j) { const u32x2 w = xs[64 * j]; x[j] = (f32x4){bf_lo(w.x) * sg * gi[j].x, bf_hi(w.x) * sg * gi[j].y, bf_lo(w.y) * sg * gi[j].z, bf_hi(w.y) * sg * gi[j].w}; }
        }
#pragma unroll
        for (int j = 0; j < 8; ++j) s += (d[j].x * d[j].x + d[j].y * d[j].y) + (d[j].z * d[j].z + d[j].w * d[j].w);
        const float rstd = 1.0f / sqrtf(wave_sum(s) * (1.f / DM) + EPS);
        float s2 = 0.f;
#pragma unroll
        for (int j = 0; j < 8; ++j) { x[j] = x[j] + d[j] * rstd * gp[j]; s2 += (x[j].x * x[j].x + x[j].y * x[j].y) + (x[j].z * x[j].z + x[j].w * x[j].w); }
        if (last) {
            f32x4* xo = (f32x4*)(A.out + O_Y + (size_t)m * DM) + lane;
#pragma unroll
            for (int j = 0; j < 8; ++j) xo[64 * j] = x[j];
        }
        if (gnext) {
            const float sig2 = sqrtf(wave_sum(s2) * (1.f / DM) + EPS), rstd2 = 1.0f / sig2;
            if (lane == 0) SIG[m] = sig2;
            u32x2* o = (u32x2*)(HB + (size_t)m * DM) + lane;
#pragma unroll
            for (int j = 0; j < 8; ++j) { u32x2 w; w.x = cvt_pk_asm(x[j].x * rstd2 * gn[j].x, x[j].y * rstd2 * gn[j].y); w.y = cvt_pk_asm(x[j].z * rstd2 * gn[j].z, x[j].w * rstd2 * gn[j].w); o[64 * j] = w; }
            if (h8) {
                unsigned* o8 = (unsigned*)(A.ws + WS_H8 + (size_t)m * DM) + lane;
#pragma unroll
                for (int j = 0; j < 8; ++j) { int w8 = 0; w8 = __builtin_amdgcn_cvt_pk_fp8_f32(x[j].x * rstd2 * gn[j].x, x[j].y * rstd2 * gn[j].y, w8, false); w8 = __builtin_amdgcn_cvt_pk_fp8_f32(x[j].z * rstd2 * gn[j].z, x[j].w * rstd2 * gn[j].w, w8, true); o8[64 * j] = (unsigned)w8; }
            }
        }
    }
}

__device__ __forceinline__ bf16x8 pack_p(const f32x16& p, int s) {
    u32x4 w; w.x = cvt_pk_asm(p[8 * s + 0], p[8 * s + 1]); w.y = cvt_pk_asm(p[8 * s + 2], p[8 * s + 3]); w.z = cvt_pk_asm(p[8 * s + 4], p[8 * s + 5]); w.w = cvt_pk_asm(p[8 * s + 6], p[8 * s + 7]);
    return __builtin_bit_cast(bf16x8, w);
}
__device__ __forceinline__ u32x4 ld_f32x8_as_bf16(const float* p) { const f32x4 a = *(const f32x4*)p, b = *(const f32x4*)(p + 4); u32x4 w; w.x = cvt_pk_asm(a.x, a.y); w.y = cvt_pk_asm(a.z, a.w); w.z = cvt_pk_asm(b.x, b.y); w.w = cvt_pk_asm(b.z, b.w); return w; }
__device__ __forceinline__ void scatter8(LAS bf16* base, int pitch, u32x4 w) {
    base[0 * pitch] = (bf16)(w.x & 0xffffu); base[1 * pitch] = (bf16)(w.x >> 16); base[2 * pitch] = (bf16)(w.y & 0xffffu); base[3 * pitch] = (bf16)(w.y >> 16);
    base[4 * pitch] = (bf16)(w.z & 0xffffu); base[5 * pitch] = (bf16)(w.z >> 16); base[6 * pitch] = (bf16)(w.w & 0xffffu); base[7 * pitch] = (bf16)(w.w >> 16);
}
__device__ __forceinline__ bf16x8 ld_vt(const LAS bf16* vp) {
    const s16x4 lo = *(const LAS s16x4*)vp, hi = *(const LAS s16x4*)(vp + 8);
    return (bf16x8){lo[0], lo[1], lo[2], lo[3], hi[0], hi[1], hi[2], hi[3]};
}

typedef short v4i16_t __attribute__((ext_vector_type(4)));
__device__ __forceinline__ s16x4 vtr(const LAS bf16* p) { return __builtin_bit_cast(s16x4, __builtin_amdgcn_ds_read_tr16_b64_v4i16((LAS v4i16_t*)p)); }
__device__ __forceinline__ bf16x8 ld_tr(const LAS bf16* p, int step) { const s16x4 lo = vtr(p), hi = vtr(p + step); return (bf16x8){lo[0], lo[1], lo[2], lo[3], hi[0], hi[1], hi[2], hi[3]}; }

constexpr int SWA_KP = 72, SWA_VP = 96;
__device__ __forceinline__ void swa_unit(Frame& F, const Args& A, int l, int unit) {
    LAS bf16* Kl = (LAS bf16*)F.lds; LAS bf16* Vl = (LAS bf16*)(F.lds + 192 * SWA_KP * 2);
    const bf16* Z = (const bf16*)(A.ws + WS_Z); bf16* OC = (bf16*)(A.ws + WS_OC);
    const bool samp = unit >= 1024;
    int b, c, kvh;
    if (!samp) { b = unit >> 8; c = (unit >> 2) & 63; kvh = unit & 3; } else { const int u2 = unit - 1024; b = u2 >> 2; c = 2; kvh = u2 & 3; }
    const size_t qrow0 = samp ? (size_t)(MP + b * 64) : (size_t)(b * SEQ + c * 64);
    const int r = F.lane & 31, h = F.lane >> 5;
    bf16x8 qf[2][4]; float sks[2];
#pragma unroll
    for (int ti = 0; ti < 2; ++ti) { const int task = F.wave + 8 * ti; const int tk = task < 12 ? task : 0;
        sks[ti] = A.sinks[l * 24 + kvh * 6 + (tk >> 1)] * LOG2E;
        const bf16* qp = Z + ZO_Q + (qrow0 + (tk & 1) * 32 + r) * ZW_Q + (kvh * 6 + (tk >> 1)) * 64 + h * 8;
#pragma unroll
        for (int ks = 0; ks < 4; ++ks) qf[ti][ks] = *(const bf16x8*)(qp + ks * 16); }
    if (!samp) {
        u32x4 kw[3], vw[3];
#pragma unroll
        for (int i = 0; i < 3; ++i) { const int id = F.tid + 512 * i, kr = id >> 3, cc = id & 7; const int pos = (c - 2) * 64 + kr, posc = pos < 0 ? 0 : pos;
            const bf16* zr = Z + ZO_KV + (size_t)(b * SEQ + posc) * ZW_KV + kvh * 64 + cc * 8; kw[i] = *(const u32x4*)zr; vw[i] = *(const u32x4*)(zr + 256); }
#pragma unroll
        for (int i = 0; i < 3; ++i) { const int id = F.tid + 512 * i, kr = id >> 3, cc = id & 7; const bool ok = (c - 2) * 64 + kr >= 0;
            *(LAS u32x4*)(Kl + kr * SWA_KP + cc * 8) = ok ? kw[i] : (u32x4){0u, 0u, 0u, 0u};
            *(LAS u32x4*)(Vl + kr * SWA_VP + cc * 8) = ok ? vw[i] : (u32x4){0u, 0u, 0u, 0u}; }
    } else {
        f32x4 ka[2][2], va[2][2]; u32x4 kz, vz;
#pragma unroll
        for (int i = 0; i < 2; ++i) { const int id = F.tid + 512 * i, kr = id >> 3, cc = id & 7; const size_t off = ((((size_t)l * DB + b) * 128 + kr) * 4 + kvh) * 64 + cc * 8;
            ka[i][0] = *(const f32x4*)(A.cache_swa_k + off); ka[i][1] = *(const f32x4*)(A.cache_swa_k + off + 4); va[i][0] = *(const f32x4*)(A.cache_swa_v + off); va[i][1] = *(const f32x4*)(A.cache_swa_v + off + 4); }
        { const int id = F.tid + 1024, kr = id >> 3, cc = id & 7; const bf16* zr = Z + ZO_KV + (size_t)(MP + b * 64 + kr - 128) * ZW_KV + kvh * 64 + cc * 8; kz = *(const u32x4*)zr; vz = *(const u32x4*)(zr + 256);
          *(LAS u32x4*)(Kl + kr * SWA_KP + cc * 8) = kz; *(LAS u32x4*)(Vl + kr * SWA_VP + cc * 8) = vz; }
#pragma unroll
        for (int i = 0; i < 2; ++i) { const int id = F.tid + 512 * i, kr = id >> 3, cc = id & 7; u32x4 kw, vw;
            kw.x = cvt_pk_bf16(ka[i][0].x, ka[i][0].y); kw.y = cvt_pk_bf16(ka[i][0].z, ka[i][0].w); kw.z = cvt_pk_bf16(ka[i][1].x, ka[i][1].y); kw.w = cvt_pk_bf16(ka[i][1].z, ka[i][1].w);
            vw.x = cvt_pk_bf16(va[i][0].x, va[i][0].y); vw.y = cvt_pk_bf16(va[i][0].z, va[i][0].w); vw.z = cvt_pk_bf16(va[i][1].x, va[i][1].y); vw.w = cvt_pk_bf16(va[i][1].z, va[i][1].w);
            *(LAS u32x4*)(Kl + kr * SWA_KP + cc * 8) = kw; *(LAS u32x4*)(Vl + kr * SWA_VP + cc * 8) = vw; }
    }
    __syncthreads();
    const int kb0 = samp ? 0 : (c >= 2 ? 0 : 2 * (2 - c));
    const LAS bf16* vlane = Vl + (4 * h + ((F.lane & 15) >> 2)) * SWA_VP + 16 * ((F.lane >> 4) & 1) + 4 * (F.lane & 3);
#pragma unroll
    for (int ti = 0; ti < 2; ++ti) {
        const int task = F.wave + 8 * ti;
        if (task < 12) {
        const int g = task >> 1, hf = task & 1, head = kvh * 6 + g;
        const size_t qrow = qrow0 + hf * 32 + r;
        f32x16 S[6];
#pragma unroll
        for (int blk = 0; blk < 6; ++blk) {
            S[blk] = (f32x16){0.f, 0.f, 0.f, 0.f, 0.f, 0.f, 0.f, 0.f, 0.f, 0.f, 0.f, 0.f, 0.f, 0.f, 0.f, 0.f};
#pragma unroll
            for (int ks = 0; ks < 4; ++ks) { const bf16x8 kf = *(const LAS bf16x8*)(Kl + (blk * 32 + r) * SWA_KP + ks * 16 + h * 8); S[blk] = __builtin_amdgcn_mfma_f32_32x32x16_bf16(kf, qf[ti][ks], S[blk], 0, 0, 0); }
        }
        const float c2 = 0.125f * LOG2E;
        float mx = -3.0e38f;
#pragma unroll
        for (int blk = 0; blk < 6; ++blk)
#pragma unroll
            for (int e = 0; e < 16; ++e) { const float v = (blk < kb0) ? -1.0e30f : S[blk][e]; S[blk][e] = v; mx = fmaxf(mx, v); }
        mx = fmaxf(mx, __shfl_xor(mx, 32));
        const float sk = sks[ti];
        const float m2 = fmaxf(mx * c2, sk);
        float sum = 0.f;
#pragma unroll
        for (int blk = 0; blk < 6; ++blk)
#pragma unroll
            for (int e = 0; e < 16; ++e) { const float p = fexp2(S[blk][e] * c2 - m2); S[blk][e] = p; sum += p; }
        sum += __shfl_xor(sum, 32);
        sum += fexp2(sk - m2);
        const float inv = 1.0f / sum;
        bf16x8 pf[6][2];
#pragma unroll
        for (int blk = 0; blk < 6; ++blk) { pf[blk][0] = pack_p(S[blk], 0); pf[blk][1] = pack_p(S[blk], 1); }
        bf16* op = OC + qrow * OCW + GW + head * 64;
#pragma unroll
        for (int dblk = 0; dblk < 2; ++dblk) {
            f32x16 O = (f32x16){0.f, 0.f, 0.f, 0.f, 0.f, 0.f, 0.f, 0.f, 0.f, 0.f, 0.f, 0.f, 0.f, 0.f, 0.f, 0.f};
#pragma unroll
            for (int blk = 0; blk < 6; ++blk)
#pragma unroll
                for (int s = 0; s < 2; ++s) { const bf16x8 vf = ld_tr(vlane + (blk * 32 + s * 16) * SWA_VP + dblk * 32, 8 * SWA_VP); O = __builtin_amdgcn_mfma_f32_32x32x16_bf16(vf, pf[blk][s], O, 0, 0, 0); }
#pragma unroll
            for (int rg = 0; rg < 4; ++rg) { u32x2 w; w.x = cvt_pk_asm(O[4 * rg] * inv, O[4 * rg + 1] * inv); w.y = cvt_pk_asm(O[4 * rg + 2] * inv, O[4 * rg + 3] * inv);
                *(u32x2*)(op + dblk * 32 + 8 * rg + 4 * h) = w; }
        }
        }
    }
}

constexpr int MEM_KP = 264, MEM_VP = 96;
template <bool samp> __device__ __forceinline__ void mem_unit_t(Frame& F, const Args& A, int l, int unit) {
    LAS bf16* Kc = (LAS bf16*)F.lds;
    const bf16* Z = (const bf16*)(A.ws + WS_Z); bf16* OC = (bf16*)(A.ws + WS_OC);
    int b, hd, qb;
    if (!samp) { b = unit >> 6; hd = (unit >> 4) & 3; qb = unit & 15; } else { const int u2 = unit - 256; b = u2 >> 2; hd = u2 & 3; qb = 0; }
    const size_t qrow0 = samp ? (size_t)(MP + b * 64) : (size_t)(b * SEQ + qb * 256);
    const bool active = samp ? (F.wave < 2) : true;
    int tidv = F.tid, lanev = F.lane;
    int r = lanev & 31, h = lanev >> 5;
    const size_t qrow = qrow0 + (active ? F.wave * 32 : 0) + r;
    const bf16* mkv = (const bf16*)(A.ws + WS_MKV) + ((size_t)l * 1024 + b * 256) * 2048 + hd * 256;
    const size_t coff = (((size_t)l * DB + b) * 256 * 4 + hd) * 256;
    bf16x8 qf[16];
    { const bf16* qp = Z + ZO_CQ + qrow * ZW_CQ + hd * 256 + h * 8;
#pragma unroll
      for (int ks = 0; ks < 16; ++ks) qf[ks] = *(const bf16x8*)(qp + ks * 16); }
    f32x4 ra[4], rb[4];
#define MEM_LOADK(ch) do { _Pragma("unroll") for (int i_ = 0; i_ < 4; ++i_) { const int id_ = tidv + 512 * i_, m_ = (ch) * 64 + (id_ >> 5), cc_ = id_ & 31; \
        if (!samp) ra[i_] = *(const f32x4*)(mkv + (size_t)m_ * 2048 + cc_ * 8); else { const float* p_ = A.cache_mem_k + coff + (size_t)m_ * 1024 + cc_ * 8; ra[i_] = *(const f32x4*)p_; rb[i_] = *(const f32x4*)(p_ + 4); } } } while (0)
#define MEM_LOADV(dc) do { _Pragma("unroll") for (int i_ = 0; i_ < 4; ++i_) { const int id_ = tidv + 512 * i_, m_ = id_ >> 3, cc_ = id_ & 7; \
        if (!samp) ra[i_] = *(const f32x4*)(mkv + (size_t)m_ * 2048 + 1024 + (dc) * 64 + cc_ * 8); else { const float* p_ = A.cache_mem_v + coff + (size_t)m_ * 1024 + (dc) * 64 + cc_ * 8; ra[i_] = *(const f32x4*)p_; rb[i_] = *(const f32x4*)(p_ + 4); } } } while (0)
#define MEM_STG(i_) (samp ? (u32x4){cvt_pk_bf16(ra[i_].x, ra[i_].y), cvt_pk_bf16(ra[i_].z, ra[i_].w), cvt_pk_bf16(rb[i_].x, rb[i_].y), cvt_pk_bf16(rb[i_].z, rb[i_].w)} : __builtin_bit_cast(u32x4, ra[i_]))
    MEM_LOADK(0);
    f32x16 S[8];
#pragma unroll
    for (int ch = 0; ch < 4; ++ch) {
        __syncthreads();
#pragma unroll
        for (int i = 0; i < 4; ++i) { const int id = tidv + 512 * i, mr = id >> 5, cc = id & 31; *(LAS u32x4*)(Kc + mr * MEM_KP + cc * 8) = MEM_STG(i); }
        __syncthreads();
        if (ch < 3) MEM_LOADK(ch + 1); else MEM_LOADV(0);
        if (active) {
#pragma unroll
            for (int blk = 0; blk < 2; ++blk) {
                f32x16 s = (f32x16){0.f, 0.f, 0.f, 0.f, 0.f, 0.f, 0.f, 0.f, 0.f, 0.f, 0.f, 0.f, 0.f, 0.f, 0.f, 0.f};
#pragma unroll
                for (int ks = 0; ks < 16; ++ks) { const bf16x8 kf = *(const LAS bf16x8*)(Kc + (blk * 32 + r) * MEM_KP + ks * 16 + h * 8); s = __builtin_amdgcn_mfma_f32_32x32x16_bf16(kf, qf[ks], s, 0, 0, 0); }
                S[ch * 2 + blk] = s;
            }
        } else {
#pragma unroll
            for (int blk = 0; blk < 2; ++blk) S[ch * 2 + blk] = (f32x16){0.f, 0.f, 0.f, 0.f, 0.f, 0.f, 0.f, 0.f, 0.f, 0.f, 0.f, 0.f, 0.f, 0.f, 0.f, 0.f};
        }
    }
    const float c2 = 0.0625f * LOG2E;
    float mx = -3.0e38f;
#pragma unroll
    for (int blk = 0; blk < 8; ++blk)
#pragma unroll
        for (int e = 0; e < 16; ++e) mx = fmaxf(mx, S[blk][e]);
    mx = fmaxf(mx, __shfl_xor(mx, 32));
    const float m2 = mx * c2;
    float sum = 0.f;
#pragma unroll
    for (int blk = 0; blk < 8; ++blk)
#pragma unroll
        for (int e = 0; e < 16; ++e) { const float p = fexp2(S[blk][e] * c2 - m2); S[blk][e] = p; sum += p; }
    sum += __shfl_xor(sum, 32);
    const float inv = 1.0f / sum;
    bf16x8 pf[8][2];
#pragma unroll
    for (int blk = 0; blk < 8; ++blk) { pf[blk][0] = pack_p(S[blk], 0); pf[blk][1] = pack_p(S[blk], 1); }
    tidv = F.wave * 64 + lane_id(); asm volatile("" : "+v"(tidv)); lanev = tidv & 63; r = lanev & 31; h = lanev >> 5;
    bf16* op = OC + (qrow0 + (active ? F.wave * 32 : 0) + r) * OCW + 3072 + hd * 256;
    const LAS bf16* vlane = Kc + (4 * h + ((lanev & 15) >> 2)) * MEM_VP + 16 * ((lanev >> 4) & 1) + 4 * (lanev & 3);
#pragma unroll 1
    for (int dc = 0; dc < 4; ++dc) {
        __syncthreads();
#pragma unroll
        for (int i = 0; i < 4; ++i) { const int id = tidv + 512 * i, m = id >> 3, cc = id & 7; *(LAS u32x4*)(Kc + m * MEM_VP + cc * 8) = MEM_STG(i); }
        __syncthreads();
        if (dc < 3) MEM_LOADV(dc + 1);
        if (active) {
#pragma unroll
            for (int dblk = 0; dblk < 2; ++dblk) {
                f32x16 O = (f32x16){0.f, 0.f, 0.f, 0.f, 0.f, 0.f, 0.f, 0.f, 0.f, 0.f, 0.f, 0.f, 0.f, 0.f, 0.f, 0.f};
#pragma unroll
                for (int blk = 0; blk < 8; ++blk)
#pragma unroll
                    for (int s = 0; s < 2; ++s) { const bf16x8 vf = ld_tr(vlane + (blk * 32 + s * 16) * MEM_VP + dblk * 32, 8 * MEM_VP); O = __builtin_amdgcn_mfma_f32_32x32x16_bf16(vf, pf[blk][s], O, 0, 0, 0); }
#pragma unroll
                for (int rg = 0; rg < 4; ++rg) { u32x2 w; w.x = cvt_pk_asm(O[4 * rg] * inv, O[4 * rg + 1] * inv); w.y = cvt_pk_asm(O[4 * rg + 2] * inv, O[4 * rg + 3] * inv);
                    *(u32x2*)(op + dc * 64 + dblk * 32 + 8 * rg + 4 * h) = w; }
            }
        }
    }
#undef MEM_LOADK
#undef MEM_LOADV
#undef MEM_STG
}
__device__ __forceinline__ void mem_unit(Frame& F, const Args& A, int l, int unit) { if (unit >= 256) mem_unit_t<true>(F, A, l, unit); else mem_unit_t<false>(F, A, l, unit); }

constexpr int GM_VP = 160;
constexpr int GM_TILE_BYTES = 128 * GM_VP * 2;
__device__ __forceinline__ void gmlp_unit(Frame& F, const Args& A, int l, int unit) {
    LAS float* st = (LAS float*)(F.lds + 2 * GM_TILE_BYTES);
    const bf16* Z = (const bf16*)(A.ws + WS_Z); bf16* OC = (bf16*)(A.ws + WS_OC);
    const bool samp = unit >= 384;
    int ch, gq; if (!samp) { ch = unit / 3; gq = unit - ch * 3; } else { const int u2 = unit - 384; ch = u2 / 3; gq = u2 - ch * 3; }
    const int L = samp ? 64 : 128;
    const size_t row0 = samp ? (size_t)(MP + ch * 64) : (size_t)ch * 128;
    u32x4 gw[4]; f32x4 lg0, lg1, lb0, lb1;
#define GM_LOAD(g_) do { _Pragma("unroll") for (int i_ = 0; i_ < 4; ++i_) { const int id_ = F.tid + 512 * i_, j_ = id_ >> 4, cc_ = id_ & 15; \
        gw[i_] = (j_ < L) ? *(const u32x4*)(Z + ZO_GV + (row0 + j_) * ZW_GV + (g_) * 128 + cc_ * 8) : (u32x4){0u, 0u, 0u, 0u}; } \
        { const float* gp_ = A.ln_v_g + (size_t)l * GW + (g_) * 128 + (F.tid & 15) * 8; const float* bp_ = A.ln_v_b + (size_t)l * GW + (g_) * 128 + (F.tid & 15) * 8; \
          lg0 = *(const f32x4*)gp_; lg1 = *(const f32x4*)(gp_ + 4); lb0 = *(const f32x4*)bp_; lb1 = *(const f32x4*)(bp_ + 4); } } while (0)
    const int grot = ch & 3;
    GM_LOAD(4 * gq + grot);
    if (F.tid < L) {
        const float* sp = (const float*)(A.ws + WS_STATS) + (row0 + F.tid) * 8; float s = 0.f, q = 0.f;
#pragma unroll
        for (int t6 = 0; t6 < 6; ++t6) { const f32x4 a = *(const f32x4*)(sp + (size_t)t6 * MT * 8), b = *(const f32x4*)(sp + (size_t)t6 * MT * 8 + 4); s += (a.x + a.z) + (b.x + b.z); q += (a.y + a.w) + (b.y + b.w); }
        const float mean = s * (1.f / GW); const float var = fmaxf(q * (1.f / GW) - mean * mean, 0.f);
        st[2 * F.tid] = mean; st[2 * F.tid + 1] = 1.0f / sqrtf(var + EPS);
    }
    __syncthreads();
    const int r = F.lane & 31, h = F.lane >> 5;
    const int iblk = samp ? ((F.wave >> 1) & 1) : (F.wave >> 1), cb0 = samp ? 2 * (F.wave & 1) + (F.wave >> 2) : 2 * (F.wave & 1), ncb = samp ? 1 : 2, nks = 2 * (iblk + 1);
#pragma unroll 1
    for (int gi = 0; gi < 4; ++gi) {
        const int g = 4 * gq + ((gi + grot) & 3);
        LAS bf16* Vl = (LAS bf16*)(F.lds + (gi & 1) * GM_TILE_BYTES);
        const bf16* wsb = (const bf16*)(A.ws + WS_WS) + ((size_t)l * 12 + g) * 128 * 128;
        bf16x8 bfr[8]; u32x2 uw[2][4];
        const float bias = A.b_s[(size_t)l * GW + g * 128 + iblk * 32 + r];
        { const bf16* bp = wsb + (size_t)(iblk * 32 + r) * 128 + h * 8;
#pragma unroll
          for (int ks = 0; ks < 8; ++ks) bfr[ks] = (ks < nks) ? *(const bf16x8*)(bp + ks * 16) : (bf16x8){0, 0, 0, 0, 0, 0, 0, 0}; }
#pragma unroll
        for (int cb = 0; cb < 2; ++cb) { const bf16* up = Z + ZO_U + (row0 + iblk * 32 + r) * ZW_U + g * 128 + (cb0 + cb) * 32 + 4 * h;
#pragma unroll
            for (int rg = 0; rg < 4; ++rg) uw[cb][rg] = (cb < ncb) ? *(const u32x2*)(up + 8 * rg) : (u32x2){0u, 0u}; }
        { const int cc = F.tid & 15;
          const f32x4 g0 = lg0, g1 = lg1, b0 = lb0, b1 = lb1;
#pragma unroll
          for (int i = 0; i < 4; ++i) {
            const int id = F.tid + 512 * i, j = id >> 4;
            if (j < L) {
            const u32x4 w = gw[i];
            const float mean = st[2 * j], rstd = st[2 * j + 1];
            float v[8];
            v[0] = (bf_lo(w.x) - mean) * rstd * g0.x + b0.x; v[1] = (bf_hi(w.x) - mean) * rstd * g0.y + b0.y; v[2] = (bf_lo(w.y) - mean) * rstd * g0.z + b0.z; v[3] = (bf_hi(w.y) - mean) * rstd * g0.w + b0.w;
            v[4] = (bf_lo(w.z) - mean) * rstd * g1.x + b1.x; v[5] = (bf_hi(w.z) - mean) * rstd * g1.y + b1.y; v[6] = (bf_lo(w.w) - mean) * rstd * g1.z + b1.z; v[7] = (bf_hi(w.w) - mean) * rstd * g1.w + b1.w;
            if (samp) { float* o = A.out + O_GV + (((size_t)l * DB + ch) * 64 + j) * GW + g * 128 + cc * 8; *(f32x4*)o = (f32x4){v[0], v[1], v[2], v[3]}; *(f32x4*)(o + 4) = (f32x4){v[4], v[5], v[6], v[7]}; }
            u32x4 pw; pw.x = cvt_pk_asm(v[0], v[1]); pw.y = cvt_pk_asm(v[2], v[3]); pw.z = cvt_pk_asm(v[4], v[5]); pw.w = cvt_pk_asm(v[6], v[7]);
            *(LAS u32x4*)(Vl + j * GM_VP + cc * 8) = pw;
            }
          } }
        __syncthreads();
        if (gi < 3) GM_LOAD(4 * gq + ((gi + 1 + grot) & 3));
#pragma unroll
        for (int cb = 0; cb < 2; ++cb) {
            if (cb < ncb) {
            const int cblk = cb0 + cb;
            const LAS bf16* alane = Vl + (8 * h + ((F.lane & 15) >> 2)) * GM_VP + cblk * 32 + 16 * ((F.lane >> 4) & 1) + 4 * (F.lane & 3);
            f32x16 acc = (f32x16){0.f, 0.f, 0.f, 0.f, 0.f, 0.f, 0.f, 0.f, 0.f, 0.f, 0.f, 0.f, 0.f, 0.f, 0.f, 0.f};
#pragma unroll
            for (int ks = 0; ks < 8; ++ks) { if (ks < nks) { const bf16x8 af = ld_tr(alane + (ks * 16) * GM_VP, 4 * GM_VP); acc = __builtin_amdgcn_mfma_f32_32x32x16_bf16(af, bfr[ks], acc, 0, 0, 0); } }
            const int i = iblk * 32 + r;
            bf16* op = OC + (row0 + i) * OCW + g * 128 + cblk * 32 + 4 * h;
#pragma unroll
            for (int rg = 0; rg < 4; ++rg) { u32x2 w;
                w.x = cvt_pk_asm((acc[4 * rg] + bias) * bf_lo(uw[cb][rg].x), (acc[4 * rg + 1] + bias) * bf_hi(uw[cb][rg].x)); w.y = cvt_pk_asm((acc[4 * rg + 2] + bias) * bf_lo(uw[cb][rg].y), (acc[4 * rg + 3] + bias) * bf_hi(uw[cb][rg].y));
                *(u32x2*)(op + 8 * rg) = w; }
            }
        }
    }
#undef GM_LOAD
}

constexpr int NU_MEM = 256 + 128, NU_SWA = 1024 + 128, NU_GM = 384 + 96, NU_MIX = NU_MEM + NU_SWA + NU_GM;
__device__ __forceinline__ void mixer_phase(Frame& F, const Args& A, int l, int rep) {
    gu32* ctr = F.ctl + CW_QUEUE + 64 * (l + 4 * rep);
    if (F.tid == 0) F.MISC[16] = __hip_atomic_fetch_add(ctr, 1u, RLX_AGENT);
    __syncthreads();
    int u = __builtin_amdgcn_readfirstlane((int)F.MISC[16]);
    while (u < NU_MIX) {
        unsigned nxt = 0u;
        if (F.tid == 0) nxt = __hip_atomic_fetch_add(ctr, 1u, RLX_AGENT);
        { int t_ = threadIdx.x; asm volatile("" : "+v"(t_)); F.tid = t_; F.lane = t_ & 63; }
        if (u < NU_MEM) mem_unit(F, A, l, u);
        else if (u < NU_MEM + NU_GM) gmlp_unit(F, A, l, u - NU_MEM);
        else swa_unit(F, A, l, u - NU_MEM - NU_GM);
        __syncthreads();
        if (F.tid == 0) F.MISC[16] = nxt;
        __syncthreads();
        u = __builtin_amdgcn_readfirstlane((int)F.MISC[16]);
    }
}

__global__ void __launch_bounds__(512, 2) trunk_fwd(Args A_unused_directly) {
    extern __shared__ __attribute__((aligned(16))) unsigned char lds[];
    Frame F;
    F.lds = (LAS unsigned char*)lds; F.MISC = (volatile LAS unsigned*)(F.lds + MISC_OFF);
    F.tid = threadIdx.x; F.lane = F.tid & 63; F.wave = __builtin_amdgcn_readfirstlane(F.tid >> 6);
    F.G = gridDim.x; { const int bx = blockIdx.x; F.vcu = (F.G % 8 == 0) ? (bx % 8) * (F.G / 8) + bx / 8 : bx; }
    { Args A; load_args(A); F.ctl = (gu32*)(A.ws + WS_CTL); }
    for (int u = F.tid; u < (LDS_BYTES - LDSCTL_OFF) / 4; u += 512) ((LAS unsigned*)(F.lds + LDSCTL_OFF))[u] = 0u;
    __syncthreads();
    XcdBarrier bar = xcd_barrier_post((unsigned*)(F.ctl + CW_BAR), F.MISC + 8);
    const int bx = (int)blockIdx.x;

    for (int cl = 0; cl < DEPTH; ++cl) { Args A; load_args(A); convert_layer(F, A, cl, F.vcu, F.G); }
    { Args A; load_args(A); p0_tables(F, A); }
    { Args A; load_args(A); p0_rows(F, A); }
    xcd_barrier(bar);

#pragma unroll 1
    for (int l = 0; l < DEPTH; ++l) {
        {
            Args A; load_args(A); const unsigned char* wl = A.ws + WS_W + (size_t)l * W_LAYER; bf16* const H = (bf16*)(A.ws + WS_H); bf16* const Z = (bf16*)(A.ws + WS_Z); bf16* const OC = (bf16*)(A.ws + WS_OC); bf16* const T1 = (bf16*)(A.ws + WS_T1); bf16* const T2 = (bf16*)(A.ws + WS_T2); (void)wl; (void)H; (void)Z; (void)OC; (void)T1; (void)T2;
            pg8::Gemm g{H, (const bf16*)(wl + W_IN), MT, C_G, DM}; pg8::StaticOrder S; S.init(MT, C_G, DM, F.G, bx, WGM_WIDE);
            pg8::EpiIn E{Z, (float*)(A.ws + WS_STATS), (const float*)(A.ws + WS_ROPE), A.out, l};
            pg8::gemm_phase(F.lds, g, S, E);
        }
        {
            Args A; load_args(A); const unsigned char* wl = A.ws + WS_W + (size_t)l * W_LAYER;
            pg8::Gemm g{(const bf16*)(A.ws + WS_H8), (const bf16*)(wl + W_G8), MT, C_G, DM / 2}; pg8::StaticOrder S; S.init(MT, C_G, DM / 2, F.G, (bx + F.G / 4) % F.G, WGM_WIDE);
            pg8::EpiGate E{(bf16*)(A.ws + WS_Z)};
            pg8::gemm_phase(F.lds, g, S, E);
        }
        {
            Args A; load_args(A); const unsigned char* wl = A.ws + WS_W + (size_t)l * W_LAYER; bf16* const H = (bf16*)(A.ws + WS_H); bf16* const Z = (bf16*)(A.ws + WS_Z); bf16* const OC = (bf16*)(A.ws + WS_OC); bf16* const T1 = (bf16*)(A.ws + WS_T1); bf16* const T2 = (bf16*)(A.ws + WS_T2); (void)wl; (void)H; (void)Z; (void)OC; (void)T1; (void)T2;
            pg8::Gemm g{(const bf16*)(A.ws + WS_MN) + (size_t)l * 1024 * DM, (const bf16*)(wl + W_MEM), 1024, 2048, DM}; pg8::StaticOrder S; S.init(1024, 2048, DM, F.G, (bx + F.G / 4) % F.G);
            pg8::EpiMemKV E{(bf16*)(A.ws + WS_MKV) + (size_t)l * 1024 * 2048, A.out + O_MKP + (size_t)l * 1024 * 1024, A.out + O_MVP + (size_t)l * 1024 * 1024};
            pg8::gemm_phase(F.lds, g, S, E);
        }
        xcd_barrier(bar);
        for (int rep = 0; rep < PROBE_REP_MIX; ++rep) { Args A; load_args(A); mixer_phase(F, A, l, rep); if (rep + 1 < PROBE_REP_MIX) xcd_barrier(bar); }
        xcd_barrier(bar);
        {
            Args A; load_args(A); const unsigned char* wl = A.ws + WS_W + (size_t)l * W_LAYER; bf16* const H = (bf16*)(A.ws + WS_H); bf16* const Z = (bf16*)(A.ws + WS_Z); bf16* const OC = (bf16*)(A.ws + WS_OC); bf16* const T1 = (bf16*)(A.ws + WS_T1); bf16* const T2 = (bf16*)(A.ws + WS_T2); (void)wl; (void)H; (void)Z; (void)OC; (void)T1; (void)T2;
            pg8::Gemm g{OC, (const bf16*)(wl + W_MG), MT, DM, OCW}; pg8::SplitOrder S; S.init(OCW, F.G, bx);
            pg8::EpiMerge E{Z, T1, (bf16*)(A.ws + WS_PARTM)};
            pg8::gemm_phase(F.lds, g, S, E);
        }
        xcd_barrier(bar);
        { Args A; load_args(A);
          int lane = F.lane; asm volatile("" : "+v"(lane));
          const bf16* PM = (const bf16*)(A.ws + WS_PARTM); bf16* T1s = (bf16*)(A.ws + WS_T1) + (size_t)MP * DM;
          for (int m = F.vcu * 8 + F.wave; m < MS; m += F.G * 8) {
              const u32x2* dr = (const u32x2*)(PM + (size_t)m * DM) + lane; u32x2* o = (u32x2*)(T1s + (size_t)m * DM) + lane;
#pragma unroll
              for (int j = 0; j < 8; ++j) { const u32x2 w0 = dr[64 * j], w1 = dr[64 * j + (size_t)MS * DM / 4], w2 = dr[64 * j + 2 * ((size_t)MS * DM / 4)], w3 = dr[64 * j + 3 * ((size_t)MS * DM / 4)];
                  u32x2 w; w.x = cvt_pk_asm((bf_lo(w0.x) + bf_lo(w1.x)) + (bf_lo(w2.x) + bf_lo(w3.x)), (bf_hi(w0.x) + bf_hi(w1.x)) + (bf_hi(w2.x) + bf_hi(w3.x)));
                  w.y = cvt_pk_asm((bf_lo(w0.y) + bf_lo(w1.y)) + (bf_lo(w2.y) + bf_lo(w3.y)), (bf_hi(w0.y) + bf_hi(w1.y)) + (bf_hi(w2.y) + bf_hi(w3.y))); o[64 * j] = w; } } }
        xcd_barrier(bar);
        {
            Args A; load_args(A); const unsigned char* wl = A.ws + WS_W + (size_t)l * W_LAYER; bf16* const H = (bf16*)(A.ws + WS_H); bf16* const Z = (bf16*)(A.ws + WS_Z); bf16* const OC = (bf16*)(A.ws + WS_OC); bf16* const T1 = (bf16*)(A.ws + WS_T1); bf16* const T2 = (bf16*)(A.ws + WS_T2); (void)wl; (void)H; (void)Z; (void)OC; (void)T1; (void)T2;
            pg8::Gemm g{T1, (const bf16*)(wl + W_O), MT, DM, DM}; pg8::SplitOrder S; S.init(DM, F.G, bx);
            pg8::EpiStoreSplit E{T2, (bf16*)(A.ws + WS_PART)};
            pg8::gemm_phase(F.lds, g, S, E);
        }
        xcd_barrier(bar);
        { Args A; load_args(A); thin_phase(F, A, (const bf16*)(A.ws + WS_T2), (const bf16*)(A.ws + WS_PART), A.norm_mix_post + (size_t)l * DM, A.norm_ffn_pre + (size_t)l * DM, A.norm_mix_pre + (size_t)l * DM, l == 0, false, false); }
        xcd_barrier(bar);
        {
            Args A; load_args(A); const unsigned char* wl = A.ws + WS_W + (size_t)l * W_LAYER; bf16* const H = (bf16*)(A.ws + WS_H); bf16* const Z = (bf16*)(A.ws + WS_Z); bf16* const OC = (bf16*)(A.ws + WS_OC); bf16* const T1 = (bf16*)(A.ws + WS_T1); bf16* const T2 = (bf16*)(A.ws + WS_T2); (void)wl; (void)H; (void)Z; (void)OC; (void)T1; (void)T2;
            pg8::Gemm g{H, (const bf16*)(wl + W_UP), MT, FF, DM}; pg8::StaticOrder S; S.init(MT, FF, DM, F.G, bx, WGM_WIDE);
            pg8::EpiStore<1> E{Z  , FF};
            pg8::gemm_phase(F.lds, g, S, E);
        }
        xcd_barrier(bar);
        {
            Args A; load_args(A); const unsigned char* wl = A.ws + WS_W + (size_t)l * W_LAYER; bf16* const H = (bf16*)(A.ws + WS_H); bf16* const Z = (bf16*)(A.ws + WS_Z); bf16* const OC = (bf16*)(A.ws + WS_OC); bf16* const T1 = (bf16*)(A.ws + WS_T1); bf16* const T2 = (bf16*)(A.ws + WS_T2); (void)wl; (void)H; (void)Z; (void)OC; (void)T1; (void)T2;
            pg8::Gemm g{Z, (const bf16*)(wl + W_DN), MT, DM, FF}; pg8::SplitOrder S; S.init(FF, F.G, bx);
            pg8::EpiStoreSplit E{T1, (bf16*)(A.ws + WS_PART)};
            pg8::gemm_phase(F.lds, g, S, E);
        }
        xcd_barrier(bar);
        { Args A; load_args(A); thin_phase(F, A, (const bf16*)(A.ws + WS_T1), (const bf16*)(A.ws + WS_PART), A.norm_ffn_post + (size_t)l * DM, (l + 1 < DEPTH) ? A.norm_mix_pre + (size_t)(l + 1) * DM : nullptr, A.norm_ffn_pre + (size_t)l * DM, false, l + 1 == DEPTH, true); }
        if (l + 1 < DEPTH) xcd_barrier(bar);
    }
}

extern "C" void kernel_launch(void* const* d_in, const int* in_sizes, int n_in, void* d_out, int out_size, void* d_ws, size_t ws_size, hipStream_t stream) {
    static int grid = 0;
    if (grid == 0) {
        if (n_in != 26 || in_sizes[0] != MP * DM || (size_t)out_size != O_END || ws_size < WS_END) {
            fprintf(stderr, "kernel_launch: unexpected problem (n_in %d, in0 %d, out %d, ws %zu; need ws >= %zu); nothing launched\n", n_in, n_in > 0 ? in_sizes[0] : -1, out_size, ws_size, (size_t)WS_END); grid = -1; return; }
        int dev = 0, cus = 0, per_cu = 0;
        if (hipGetDevice(&dev) != hipSuccess || hipDeviceGetAttribute(&cus, hipDeviceAttributeMultiprocessorCount, dev) != hipSuccess) { fprintf(stderr, "kernel_launch: device query failed\n"); grid = -1; return; }
        if (hipFuncSetAttribute((const void*)trunk_fwd, hipFuncAttributeMaxDynamicSharedMemorySize, LDS_BYTES) != hipSuccess) { fprintf(stderr, "kernel_launch: hipFuncSetAttribute failed\n"); grid = -1; return; }
        if (hipOccupancyMaxActiveBlocksPerMultiprocessor(&per_cu, (const void*)trunk_fwd, 512, LDS_BYTES) != hipSuccess || per_cu < 1)
            fprintf(stderr, "kernel_launch: note: occupancy query reports %d workgroups per CU\n", per_cu);
        (void)hipGetLastError();
        grid = cus;
    }
    if (grid < 0) return;
    if (hipMemsetAsync((char*)d_ws + WS_CTL, 0, CTL_ZERO_BYTES, stream) != hipSuccess) { fprintf(stderr, "kernel_launch: memset failed\n"); return; }
    Args a{};
    const float** ap = (const float**)&a;
    for (int i = 0; i < 26; ++i) ap[i] = (const float*)d_in[i];
    a.out = (float*)d_out; a.ws = (unsigned char*)d_ws;
    hipLaunchKernelGGL(trunk_fwd, dim3(grid), dim3(512), LDS_BYTES, stream, a);
    const hipError_t le = hipPeekAtLastError();
    if (le != hipSuccess) fprintf(stderr, "kernel_launch: launch failed: %s\n", hipGetErrorName(le));
}
```
